# Optimizing an MI355X kernel written in HIP

```python
import jax, jax.numpy as jnp
from jax import lax
import numpy as np

D_MODEL = 2048
BATCH = 8
SEQ = 4096
DEPTH = 4

DILATED_PAIRS = ((128, 1), (512, 4), (2048, 16))
N_A_GROUPS = len(DILATED_PAIRS)
A_HEAD_DIM = 128
A_WIDTH = D_MODEL // 4
A_HEADS_PER_GROUP = A_WIDTH // A_HEAD_DIM
A_HEADS = N_A_GROUPS * A_HEADS_PER_GROUP
GLA_HEADS = 4
GLA_DV_TOTAL = 3 * D_MODEL // 8
GLA_DK_TOTAL = GLA_DV_TOTAL // 2
GLA_DV = GLA_DV_TOTAL // GLA_HEADS
GLA_DK = GLA_DK_TOTAL // GLA_HEADS
GLA_GATE_RANK = 16
GLA_TAU = 16.0
GLA_CHUNK = 64
SGU_WIDTH = 3 * D_MODEL // 8
SGU_GROUPS = 4
SGU_CHUNK = 128
N_BRANCHES = 3
MIX_WIDTH = A_WIDTH + GLA_DV_TOTAL + SGU_WIDTH
D_FFN = ((8 * D_MODEL + 3 * 256 - 1) // (3 * 256)) * 256
REL_BUCKETS = 32
REL_MAX_DIST = 2048
EPS = 1e-6
IN_WIDTHS = (N_A_GROUPS * A_WIDTH, N_A_GROUPS * A_WIDTH, N_A_GROUPS * A_WIDTH,
             GLA_DK_TOTAL, GLA_DK_TOTAL, GLA_DV_TOTAL, GLA_GATE_RANK,
             SGU_WIDTH, SGU_WIDTH,
             D_MODEL, D_MODEL, D_MODEL)
D_IN = sum(IN_WIDTHS)

kernel_name = "hybrid_dilated_gla_sgu_gated_block"


def rms_norm(x, g):
    xf = x.astype(jnp.float32)
    y = xf * lax.rsqrt(jnp.mean(xf * xf, axis=-1, keepdims=True) + EPS)
    return (y * g.astype(jnp.float32)).astype(x.dtype)


def layer_norm(x, g, b):
    xf = x.astype(jnp.float32)
    mu = jnp.mean(xf, axis=-1, keepdims=True)
    xc = xf - mu
    y = xc * lax.rsqrt(jnp.mean(xc * xc, axis=-1, keepdims=True) + EPS)
    return (y * g.astype(jnp.float32) + b.astype(jnp.float32)).astype(x.dtype)


def t5_causal_bucket(dist):
    max_exact = REL_BUCKETS // 2
    d = np.maximum(dist, 1)
    large = max_exact + (np.log(d / max_exact) / np.log(REL_MAX_DIST / max_exact)
                         * (REL_BUCKETS - max_exact)).astype(np.int64)
    large = np.minimum(large, REL_BUCKETS - 1)
    return np.where(dist < max_exact, dist, large).astype(np.int32)


def dilated_window_attention(q, k, v, bias_heads, window, dilation):
    B, S, H, Dh = q.shape
    n_back = window // dilation
    blk = n_back
    L = S // dilation
    nb = -(-L // blk)
    Lp = nb * blk

    def to_sub(t):
        t = t.reshape(B, L, dilation, H, Dh).transpose(0, 2, 3, 1, 4)
        return jnp.pad(t, ((0, 0), (0, 0), (0, 0), (0, Lp - L), (0, 0)))

    def band(t):
        tp = jnp.pad(t, ((0, 0), (0, 0), (0, 0), (blk, 0), (0, 0))).reshape(B, dilation, H, nb + 1, blk, Dh)
        return jnp.concatenate([tp[:, :, :, :-1], tp[:, :, :, 1:]], axis=-2)

    qb = to_sub(q).reshape(B, dilation, H, nb, blk, Dh)
    kb = band(to_sub(k))
    vb = band(to_sub(v))

    i = np.arange(blk)[:, None]
    j = np.arange(2 * blk)[None, :]
    sub_dist = i + blk - j
    blk_id = np.arange(nb)[:, None, None]
    valid = (sub_dist >= 0) & (sub_dist <= n_back) & (blk_id * blk - blk + j >= 0)
    bucket = t5_causal_bucket(np.clip(sub_dist, 0, None) * dilation)
    bias = jnp.moveaxis(jnp.take(bias_heads, bucket, axis=0), -1, 0)

    logits = jnp.einsum('brhnqd,brhnkd->brhnqk', qb, kb) * (Dh ** -0.5) + bias[:, None]
    logits = jnp.where(valid, logits, -jnp.inf)
    m = jnp.max(logits, axis=-1, keepdims=True)
    p = jnp.exp(logits - m)
    s = jnp.sum(p, axis=-1, keepdims=True)
    o = jnp.einsum('brhnqk,brhnkd->brhnqd', p, vb) / s
    lse = (m + jnp.log(s))[..., 0]

    o = o.reshape(B, dilation, H, Lp, Dh)[:, :, :, :L].transpose(0, 3, 1, 2, 4).reshape(B, S, H, Dh)
    lse = lse.reshape(B, dilation, H, Lp)[..., :L].transpose(0, 3, 1, 2).reshape(B, S, H)
    return o, lse


def dilated_mixer(aq, ak, av, gq, gk, rel_bias):
    B, S, _ = aq.shape
    shp = (B, S, N_A_GROUPS, A_HEADS_PER_GROUP, A_HEAD_DIM)
    q = rms_norm(aq.reshape(shp), gq).astype(jnp.float32)
    k = rms_norm(ak.reshape(shp), gk).astype(jnp.float32)
    v = av.reshape(shp).astype(jnp.float32)
    outs, lses = [], []
    for gi, (window, dilation) in enumerate(DILATED_PAIRS):
        heads = slice(gi * A_HEADS_PER_GROUP, (gi + 1) * A_HEADS_PER_GROUP)
        o, lse = dilated_window_attention(q[:, :, gi], k[:, :, gi], v[:, :, gi],
                                          rel_bias[:, heads].astype(jnp.float32), window, dilation)
        outs.append(o)
        lses.append(lse)
    wts = jax.nn.softmax(jnp.stack(lses), axis=0)[..., None]
    o = jnp.sum(wts * jnp.stack(outs), axis=0)
    return o.reshape(B, S, A_WIDTH)


def gla_mixer(bq, bk, bv, b_gate_low, w_gate_up, b_gate, g_out):
    B, S, _ = bq.shape
    f32 = jnp.float32
    q = bq.reshape(B, S, GLA_HEADS, GLA_DK).astype(f32) * (GLA_DK ** -0.5)
    k = bk.reshape(B, S, GLA_HEADS, GLA_DK).astype(f32)
    v = bv.reshape(B, S, GLA_HEADS, GLA_DV).astype(f32)
    log_a = jax.nn.log_sigmoid((b_gate_low @ w_gate_up + b_gate).astype(f32)) / GLA_TAU
    log_a = log_a.reshape(B, S, GLA_HEADS, GLA_DK)
    n = S // GLA_CHUNK

    def chunks(t):
        return t.reshape(B, n, GLA_CHUNK, GLA_HEADS, t.shape[-1]).transpose(1, 0, 3, 2, 4)

    causal = np.tril(np.ones((GLA_CHUNK, GLA_CHUNK), dtype=bool))[:, :, None]

    def step(state, inp):
        qc, kc, vc, ac = inp
        b = jnp.cumsum(ac, axis=-2)
        inter = jnp.einsum('bhtk,bhkv->bhtv', qc * jnp.exp(b), state)
        diff = b[:, :, :, None, :] - b[:, :, None, :, :]
        decay = jnp.exp(jnp.where(causal, diff, -jnp.inf))
        scores = jnp.einsum('bhtk,bhsk,bhtsk->bhts', qc, kc, decay)
        intra = jnp.einsum('bhts,bhsv->bhtv', scores, vc)
        b_last = b[:, :, -1:, :]
        new_state = (jnp.exp(b_last[:, :, 0, :])[..., None] * state
                     + jnp.einsum('bhsk,bhsv->bhkv', kc * jnp.exp(b_last - b), vc))
        return new_state, inter + intra

    state0 = jnp.zeros((B, GLA_HEADS, GLA_DK, GLA_DV), f32)
    _, o = lax.scan(step, state0, (chunks(q), chunks(k), chunks(v), chunks(log_a)))
    o = o.transpose(1, 0, 3, 2, 4).reshape(B, S, GLA_HEADS, GLA_DV)
    o = rms_norm(o, g_out)
    return o.reshape(B, S, GLA_DV_TOTAL)


def sgu_mixer(cu, cv, ln_g, ln_b, w_s, b_s):
    B, S, _ = cu.shape
    u = jax.nn.gelu(cu)
    v = layer_norm(jax.nn.gelu(cv), ln_g, ln_b)
    n = S // SGU_CHUNK
    vg = v.reshape(B, n, SGU_CHUNK, SGU_GROUPS, SGU_WIDTH // SGU_GROUPS)
    mask = np.tril(np.ones((SGU_CHUNK, SGU_CHUNK), dtype=bool))
    w = jnp.where(mask, w_s, jnp.zeros_like(w_s))
    f = jnp.einsum('gts,bnsgc->bntgc', w, vg) + b_s.T[None, None, :, :, None]
    return u * f.reshape(B, S, SGU_WIDTH)


def setup_inputs(seed: int = 0) -> dict:
    key = jax.random.key(seed)
    ks = jax.random.split(key, 20)
    nrm = jax.random.normal
    f32 = jnp.float32
    x = nrm(ks[0], (BATCH, SEQ, D_MODEL), f32)
    rel_bias = 0.5 * nrm(ks[1], (REL_BUCKETS, A_HEADS), f32)
    norm1_g = 1.0 + 0.02 * nrm(ks[2], (DEPTH, D_MODEL), f32)
    w_in = nrm(ks[3], (DEPTH, D_MODEL, D_IN), f32) * D_MODEL ** -0.5
    q_norm_g = 1.0 + 0.02 * nrm(ks[4], (DEPTH, A_HEAD_DIM), f32)
    k_norm_g = 1.0 + 0.02 * nrm(ks[5], (DEPTH, A_HEAD_DIM), f32)
    gla_gate_up = nrm(ks[6], (DEPTH, GLA_GATE_RANK, GLA_DK_TOTAL), f32) * GLA_GATE_RANK ** -0.5
    gla_gate_b = 0.1 * nrm(ks[7], (DEPTH, GLA_DK_TOTAL), f32)
    gla_out_g = 1.0 + 0.02 * nrm(ks[8], (DEPTH, GLA_DV), f32)
    sgu_ln_g = 1.0 + 0.02 * nrm(ks[9], (DEPTH, SGU_WIDTH), f32)
    sgu_ln_b = 0.02 * nrm(ks[10], (DEPTH, SGU_WIDTH), f32)
    sgu_w = nrm(ks[11], (DEPTH, SGU_GROUPS, SGU_CHUNK, SGU_CHUNK), f32) * SGU_CHUNK ** -0.5
    sgu_b = 1.0 + 0.02 * nrm(ks[12], (DEPTH, SGU_GROUPS, SGU_CHUNK), f32)
    w_branch = jnp.concatenate([
        nrm(ks[13], (DEPTH, A_WIDTH, D_MODEL), f32) * A_WIDTH ** -0.5,
        nrm(ks[14], (DEPTH, GLA_DV_TOTAL, D_MODEL), f32) * GLA_DV_TOTAL ** -0.5,
        nrm(ks[15], (DEPTH, SGU_WIDTH, D_MODEL), f32) * SGU_WIDTH ** -0.5], axis=1)
    w_out = nrm(ks[16], (DEPTH, D_MODEL, D_MODEL), f32) * D_MODEL ** -0.5
    norm2_g = 1.0 + 0.02 * nrm(ks[17], (DEPTH, D_MODEL), f32)
    w_ffn_in = nrm(ks[18], (DEPTH, D_MODEL, 2 * D_FFN), f32) * D_MODEL ** -0.5
    w_ffn_out = nrm(ks[19], (DEPTH, D_FFN, D_MODEL), f32) * D_FFN ** -0.5
    return dict(x=x, rel_bias=rel_bias, norm1_g=norm1_g, w_in=w_in, q_norm_g=q_norm_g, k_norm_g=k_norm_g,
                gla_gate_up=gla_gate_up, gla_gate_b=gla_gate_b, gla_out_g=gla_out_g,
                sgu_ln_g=sgu_ln_g, sgu_ln_b=sgu_ln_b, sgu_w=sgu_w, sgu_b=sgu_b,
                w_branch=w_branch, w_out=w_out, norm2_g=norm2_g, w_ffn_in=w_ffn_in, w_ffn_out=w_ffn_out)


def reference(x, rel_bias, norm1_g, w_in, q_norm_g, k_norm_g, gla_gate_up, gla_gate_b, gla_out_g,
              sgu_ln_g, sgu_ln_b, sgu_w, sgu_b, w_branch, w_out, norm2_g, w_ffn_in, w_ffn_out):
    in_splits = [int(s) for s in np.cumsum(IN_WIDTHS)[:-1]]
    branch_splits = [A_WIDTH, A_WIDTH + GLA_DV_TOTAL]
    for l in range(DEPTH):
        h = rms_norm(x, norm1_g[l])
        (aq, ak, av, bq, bk, bv, b_gate_low, cu, cv,
         gate_a, gate_b, gate_c) = jnp.split(h @ w_in[l], in_splits, axis=-1)
        o_a = dilated_mixer(aq, ak, av, q_norm_g[l], k_norm_g[l], rel_bias).astype(x.dtype)
        o_b = gla_mixer(bq, bk, bv, b_gate_low, gla_gate_up[l], gla_gate_b[l], gla_out_g[l]).astype(x.dtype)
        o_c = sgu_mixer(cu, cv, sgu_ln_g[l], sgu_ln_b[l], sgu_w[l], sgu_b[l])
        p_a, p_b, p_c = jnp.split(w_branch[l], branch_splits, axis=0)
        y = (jax.nn.sigmoid(gate_a) * (o_a @ p_a)
             + jax.nn.sigmoid(gate_b) * (o_b @ p_b)
             + jax.nn.sigmoid(gate_c) * (o_c @ p_c))
        x = x + y @ w_out[l]
        h = rms_norm(x, norm2_g[l])
        f_gate, f_up = jnp.split(h @ w_ffn_in[l], 2, axis=-1)
        x = x + (jax.nn.silu(f_gate) * f_up) @ w_ffn_out[l]
    return x
```

```cpp
#include <hip/hip_runtime.h>
#include <cstdio>
#include <cstdint>

#ifndef MK_MULTI
#define MK_MULTI 0
#endif

#define LAS __attribute__((address_space(3)))
#define GAS __attribute__((address_space(1)))
typedef unsigned short bf16_t;
typedef short bf16x8 __attribute__((ext_vector_type(8)));
typedef short s16x4 __attribute__((ext_vector_type(4)));
typedef float f32x4 __attribute__((ext_vector_type(4)));
typedef float f32x2 __attribute__((ext_vector_type(2)));
typedef unsigned u32x4 __attribute__((ext_vector_type(4)));
typedef unsigned u32x2 __attribute__((ext_vector_type(2)));

constexpr int D = 2048, BATCH = 8, SEQ = 4096, DEPTH = 4, M = BATCH * SEQ;
constexpr int NZ = 14080;
constexpr int ZQ = 0, ZK = 1536, ZV = 3072, ZBQ = 4608, ZBK = 4992, ZBV = 5376, ZCU = 6144, ZCV = 6912, ZGA = 7680, ZGB = 9728, ZGC = 11776, ZGL = 13824;
constexpr int DIN = 13840, DFF = 5632, NFI = 2 * DFF;
constexpr int GLA_DK = 96, GLA_DV = 192, NCHK = SEQ / 64;
constexpr float EPS = 1e-6f;
constexpr int NT = 512, NWAVES = 8;

constexpr size_t al256(size_t x) { return (x + 255) & ~(size_t)255; }
constexpr size_t WS_CTL = 0, CTL_ZERO_BYTES = 4u << 20;
typedef unsigned long long rs_t;
constexpr float RS_SCALE = 16777216.0f, RS_INV = 1.0f / 16777216.0f;
constexpr size_t WS_RS1 = 256u << 10;
constexpr size_t WS_RS2 = WS_RS1 + (size_t)DEPTH * M * 8;
static_assert(WS_RS2 + (size_t)DEPTH * M * 8 <= CTL_ZERO_BYTES, "RS buffers inside the zeroed region");
constexpr int N8 = 10752, NB = 3328;
constexpr float W8_SCALE = 256.0f, W8_INV = 1.0f / 256.0f;
constexpr size_t WS_WIN = CTL_ZERO_BYTES;
constexpr size_t WS_W8 = WS_WIN + (size_t)NB * D * 2;
constexpr size_t WS_XB8 = WS_W8 + (size_t)N8 * D;
constexpr size_t WS_WBR = WS_XB8 + (size_t)M * D;
constexpr size_t WS_WO = WS_WBR + (size_t)D * D * 2;
constexpr size_t WS_WFI = WS_WO + (size_t)D * D * 2;
constexpr size_t WS_WFO = WS_WFI + (size_t)NFI * D * 2;
constexpr size_t WS_XN = WS_WFO + (size_t)D * DFF * 2;
constexpr size_t WS_Y = WS_XN + (size_t)M * D * 2;
constexpr size_t WS_OMIX = WS_Y + (size_t)M * D * 2;
constexpr size_t WS_Z = WS_OMIX + (size_t)M * D * 2;
constexpr size_t WS_SP = WS_Z + (size_t)M * NZ * 2;
constexpr size_t WS_QT = WS_SP + (size_t)BATCH * NCHK * 4 * GLA_DV * GLA_DK * 2;
constexpr size_t WS_KT = WS_QT + (size_t)M * 384 * 2;
constexpr size_t WS_DL = WS_KT + (size_t)M * 384 * 2;
constexpr size_t WS_LSE = WS_DL + (size_t)BATCH * NCHK * 4 * GLA_DK * 4;
constexpr size_t WS_END = WS_LSE + (size_t)3 * M * 4 * 4;
constexpr size_t OUT_SL = 0;
constexpr size_t OUT_AO = OUT_SL + (size_t)BATCH * NCHK * 4 * GLA_DV * GLA_DK * 2;
static_assert(OUT_AO + (size_t)3 * M * 512 * 2 <= (size_t)M * D * 4, "scratch fits in d_out");
constexpr int CW_BAR = 4096;

typedef __bf16 bf16x2_t __attribute__((ext_vector_type(2)));
__device__ __forceinline__ unsigned cvt_pk_bf16(float lo, float hi) { const f32x2 v = {lo, hi}; return __builtin_bit_cast(unsigned, __builtin_convertvector(v, bf16x2_t)); }
__device__ __forceinline__ float bflo(unsigned w) { return __uint_as_float(w << 16); }
__device__ __forceinline__ float bfhi(unsigned w) { return __uint_as_float(w & 0xffff0000u); }
__device__ __forceinline__ float fast_rcp(float x) { return __builtin_amdgcn_rcpf(x); }
__device__ __forceinline__ float sigmoidf_(float x) { return fast_rcp(1.0f + __expf(-x)); }
__device__ __forceinline__ float gelu_tanh(float x) { const float u = 0.7978845608028654f * (x + 0.044715f * x * x * x); return x * fast_rcp(1.0f + __expf(-2.0f * u)); }
__device__ __forceinline__ float wave_sum(float v) {
#pragma unroll
    for (int o = 1; o < 64; o <<= 1) v += __shfl_xor(v, o);
    return v;
}
__device__ __forceinline__ int opq_tid() { int t = threadIdx.x; asm volatile("" : "+v"(t)); return t; }
#define LDS_WAIT() asm volatile("s_waitcnt lgkmcnt(0)" ::: "memory")
#define WG_SYNC() asm volatile("s_waitcnt lgkmcnt(0)\n\ts_barrier" ::: "memory")
#define VM_WAIT() asm volatile("s_waitcnt vmcnt(0)" ::: "memory")

namespace pg8 {
constexpr int BM = 256, BK = 64, HALF = 128, HTB = HALF * BK * 2, STAGE_BYTES = 8 * HTB, NXCD = 8;
typedef int v4i_t __attribute__((ext_vector_type(4)));
typedef int v8i_t __attribute__((ext_vector_type(8)));
__host__ __device__ __forceinline__ int lds_byte(int r, int c) { const int st = (r >> 4) * 2 + (c >> 5), rr = r & 15, cc = c & 31, ob = rr * 64 + cc * 2; return st * 1024 + (ob ^ (((ob >> 9) & 1) << 5)); }
__host__ __device__ __forceinline__ void stage_rc(int b, int& R, int& C) { const int st = b / 1024, sb = b % 1024, swz = sb ^ (((sb >> 9) & 1) << 5); R = (st >> 1) * 16 + swz / 64; C = (st & 1) * 32 + (swz % 64) / 2; }
__host__ __device__ __forceinline__ void stage_rc8(int b, int& R, int& Cb) { const int rb = b >> 11, within = b & 2047, slot = within >> 5, half = (within >> 4) & 1, fq = slot >> 4, fr = slot & 15, k = half ^ (fq & 1); R = 16 * rb + fr; Cb = 64 * k + 16 * fq; }
__host__ __device__ __forceinline__ int perm32(int rho) { const int n = rho >> 4, i = rho & 15; return 8 * (i >> 2) + 4 * n + (i & 3); }
struct Unit { int pm, pn, br; };
struct Gemm { const void* A; const void* Bt; int M, N, K, lda, ldb; };
struct StaticOrder {
    int nM, nN, nwg, G, c, full, c0, extra, nbr, wgm;
    __host__ __device__ void init(int M_, int N_, int G_, int c_) { nM = M_ / BM; nN = N_ / BM; nwg = nM * nN; G = G_; c = c_; full = 0x3fffffff; c0 = 0; extra = 0; nbr = 1; wgm = 4; }
    __host__ __device__ bool next(int i, Unit& u) const {
        long L; u.br = 0;
        if (nbr > 1) { u.br = i % nbr; i /= nbr; }
        if (i < full) L = (long)i * G + c; else { const int j = i - full; if (c < c0 || j >= extra) return false; L = (long)full * G + (long)(c - c0) * extra + j; }
        if (L >= nwg) return false;
        int wgid = (int)L; const int xcd = wgid % NXCD; { const int q = nwg / NXCD, r = nwg % NXCD, off = wgid / NXCD; wgid = (xcd < r ? xcd * (q + 1) : r * (q + 1) + (xcd - r) * q) + off; }
        const int nig = wgm * nN, gid = wgid / nig, fm = gid * wgm, gsz = (nM - fm) < wgm ? (nM - fm) : wgm;
        u.pm = fm + ((wgid % nig) % gsz); u.pn = ((wgid % nig) / gsz + ((nwg % (NXCD * nig)) == 0 ? xcd * (nN / NXCD) : 0)) % nN; return true;
    }
};
struct EpiStoreBf16 {
    static constexpr bool PERM = true, ROWSCALE = true;
    bf16_t* O; int ldc; const rs_t* rs; int split, off_lo, off_hi; float mul; bool sig;
    __device__ __forceinline__ void operator()(const f32x4 (&acc)[2][2][4][2], const Unit& u, int wr, int wc, int fr, int fq, const LAS float* rsl) const {
        const int row0 = u.pm * BM + wr * 64 + fr, col0 = (u.pn < split ? off_lo + u.pn * BM : off_hi + (u.pn - split) * BM) + wc * 32 + 8 * fq;
        const bool sg = sig && u.pn >= split;
#pragma unroll
        for (int ai = 0; ai < 2; ++ai)
#pragma unroll
            for (int m = 0; m < 4; ++m) { bf16_t* rowp = O + (size_t)(row0 + ai * HALF + m * 16) * ldc + col0;
                const float sc = rsl[wr * 64 + fr + ai * HALF + m * 16] * mul;
#pragma unroll
                for (int bj = 0; bj < 2; ++bj) { f32x4 v0 = acc[ai][bj][m][0] * sc, v1 = acc[ai][bj][m][1] * sc;
                    if (sg) {
#pragma unroll
                        for (int j = 0; j < 4; ++j) { v0[j] = fmaxf(sigmoidf_(v0[j]), 1e-30f); v1[j] = fmaxf(sigmoidf_(v1[j]), 1e-30f); } }
                    u32x4 w; w.x = cvt_pk_bf16(v0[0], v0[1]); w.y = cvt_pk_bf16(v0[2], v0[3]); w.z = cvt_pk_bf16(v1[0], v1[1]); w.w = cvt_pk_bf16(v1[2], v1[3]);
                    __builtin_nontemporal_store(w, (u32x4*)(rowp + bj * HALF)); } }
    }
};
struct EpiGate {
    static constexpr bool PERM = true, ROWSCALE = false;
    bf16_t* Y; const bf16_t* G; int ldy, ldg;
    static __device__ __forceinline__ float e_neg(float g) { return __expf(-__builtin_amdgcn_fmed3f(g, -30.0f, 30.0f)); }
    __device__ __forceinline__ void operator()(f32x4 (&acc)[2][2][4][2], const Unit& u, int wr, int wc, int fr, int fq, const LAS float*) const {
        const int row0 = u.pm * BM + wr * 64 + fr, col0 = u.pn * BM + wc * 32 + 8 * fq; const bf16_t* Gb = G + u.br * D;
        if (u.br < 2) {
#pragma unroll
            for (int ai = 0; ai < 2; ++ai) {
                u32x4 g0[4][2], g1[4][2];
#pragma unroll
                for (int m = 0; m < 4; ++m) { const size_t row = (size_t)(row0 + ai * HALF + m * 16);
#pragma unroll
                    for (int bj = 0; bj < 2; ++bj) { g0[m][bj] = *(const u32x4*)(Gb + row * ldg + col0 + bj * HALF); g1[m][bj] = *(const u32x4*)(Gb + D + row * ldg + col0 + bj * HALF); } }
#pragma unroll
                for (int m = 0; m < 4; ++m)
#pragma unroll
                    for (int bj = 0; bj < 2; ++bj) { const u32x4 a = g0[m][bj], b = g1[m][bj];
                        const unsigned aw[4] = {a.x, a.y, a.z, a.w}, bw[4] = {b.x, b.y, b.z, b.w};
#pragma unroll
                        for (int q = 0; q < 4; ++q) {
                            const float rl = bflo(aw[q]) * fast_rcp(bflo(bw[q])), rh = bfhi(aw[q]) * fast_rcp(bfhi(bw[q]));
                            acc[ai][bj][m][q >> 1][2 * (q & 1)] *= rl; acc[ai][bj][m][q >> 1][2 * (q & 1) + 1] *= rh; } }
                asm volatile("" ::: "memory"); }
        } else {
#pragma unroll
            for (int ai = 0; ai < 2; ++ai) {
                u32x4 g[4][2];
#pragma unroll
                for (int m = 0; m < 4; ++m) { const size_t row = (size_t)(row0 + ai * HALF + m * 16);
#pragma unroll
                    for (int bj = 0; bj < 2; ++bj) g[m][bj] = *(const u32x4*)(Gb + row * ldg + col0 + bj * HALF); }
#pragma unroll
                for (int m = 0; m < 4; ++m) { const size_t row = (size_t)(row0 + ai * HALF + m * 16);
#pragma unroll
                    for (int bj = 0; bj < 2; ++bj) { const f32x4 v0 = acc[ai][bj][m][0], v1 = acc[ai][bj][m][1]; const u32x4 gg = g[m][bj];
                        float o[8];
                        o[0] = v0[0] * bflo(gg.x); o[1] = v0[1] * bfhi(gg.x); o[2] = v0[2] * bflo(gg.y); o[3] = v0[3] * bfhi(gg.y);
                        o[4] = v1[0] * bflo(gg.z); o[5] = v1[1] * bfhi(gg.z); o[6] = v1[2] * bflo(gg.w); o[7] = v1[3] * bfhi(gg.w);
                        u32x4 w; w.x = cvt_pk_bf16(o[0], o[1]); w.y = cvt_pk_bf16(o[2], o[3]); w.z = cvt_pk_bf16(o[4], o[5]); w.w = cvt_pk_bf16(o[6], o[7]);
                        *(u32x4*)(Y + row * ldy + col0 + bj * HALF) = w; } }
                asm volatile("" ::: "memory"); }
        }
    }
};
struct EpiRes {
    static constexpr bool PERM = true, ROWSCALE = false;
    bf16_t* xb; float* outf; int ldc; rs_t* rs; unsigned char* xb8;
    __device__ __forceinline__ void operator()(const f32x4 (&acc)[2][2][4][2], const Unit& u, int wr, int wc, int fr, int fq, const LAS float*) const {
        const int row0 = u.pm * BM + wr * 64 + fr, col0 = u.pn * BM + wc * 32 + 8 * fq;
#pragma unroll
        for (int ai = 0; ai < 2; ++ai) {
            u32x4 bs[4][2];
#pragma unroll
            for (int m = 0; m < 4; ++m) { const size_t off = (size_t)(row0 + ai * HALF + m * 16) * ldc + col0;
#pragma unroll
                for (int bj = 0; bj < 2; ++bj) bs[m][bj] = *(const u32x4*)(xb + off + bj * HALF); }
#pragma unroll
            for (int m = 0; m < 4; ++m) { const size_t off = (size_t)(row0 + ai * HALF + m * 16) * ldc + col0; float ss = 0.f;
#pragma unroll
                for (int bj = 0; bj < 2; ++bj) { const u32x4 b4 = bs[m][bj];
                    const f32x4 o0 = (f32x4){bflo(b4.x), bfhi(b4.x), bflo(b4.y), bfhi(b4.y)} + acc[ai][bj][m][0], o1 = (f32x4){bflo(b4.z), bfhi(b4.z), bflo(b4.w), bfhi(b4.w)} + acc[ai][bj][m][1];
                    if (outf) { *(f32x4*)(outf + off + bj * HALF) = o0; *(f32x4*)(outf + off + bj * HALF + 4) = o1; }
                    else { u32x4 w; w.x = cvt_pk_bf16(o0[0], o0[1]); w.y = cvt_pk_bf16(o0[2], o0[3]); w.z = cvt_pk_bf16(o1[0], o1[1]); w.w = cvt_pk_bf16(o1[2], o1[3]); *(u32x4*)(xb + off + bj * HALF) = w;
                        ss += ((o0[0] * o0[0] + o0[1] * o0[1]) + (o0[2] * o0[2] + o0[3] * o0[3])) + ((o1[0] * o1[0] + o1[1] * o1[1]) + (o1[2] * o1[2] + o1[3] * o1[3])); }
                    if (xb8) { u32x2 q; q.x = 0u; q.y = 0u; q.x = __builtin_amdgcn_cvt_pk_fp8_f32(o0[0], o0[1], q.x, false); q.x = __builtin_amdgcn_cvt_pk_fp8_f32(o0[2], o0[3], q.x, true);
                        q.y = __builtin_amdgcn_cvt_pk_fp8_f32(o1[0], o1[1], q.y, false); q.y = __builtin_amdgcn_cvt_pk_fp8_f32(o1[2], o1[3], q.y, true); *(u32x2*)(xb8 + off + bj * HALF) = q; } }
                if (!outf) { ss += __shfl_xor(ss, 16); ss += __shfl_xor(ss, 32); if (fq == 0) __hip_atomic_fetch_add(rs + row0 + ai * HALF + m * 16, (rs_t)(ss * RS_SCALE + 0.5f), __ATOMIC_RELAXED, __HIP_MEMORY_SCOPE_AGENT); } }
            asm volatile("" ::: "memory"); }
    }
};
struct EpiSwiGLU {
    static constexpr bool PERM = true, ROWSCALE = true;
    bf16_t* H; int ldh; const rs_t* rs;
    __device__ __forceinline__ void operator()(const f32x4 (&acc)[2][2][4][2], const Unit& u, int wr, int wc, int fr, int fq, const LAS float* rsl) const {
        const int row0 = u.pm * BM + wr * 64 + fr, col0 = u.pn * HALF + wc * 32 + 8 * fq;
#pragma unroll
        for (int ai = 0; ai < 2; ++ai)
#pragma unroll
            for (int m = 0; m < 4; ++m) { const float sc = rsl[wr * 64 + fr + ai * HALF + m * 16];
                const f32x4 g0 = acc[ai][0][m][0] * sc, g1 = acc[ai][0][m][1] * sc, u0 = acc[ai][1][m][0] * sc, u1 = acc[ai][1][m][1] * sc;
                float o[8];
#pragma unroll
                for (int j = 0; j < 4; ++j) { o[j] = g0[j] * sigmoidf_(g0[j]) * u0[j]; o[4 + j] = g1[j] * sigmoidf_(g1[j]) * u1[j]; }
                u32x4 w; w.x = cvt_pk_bf16(o[0], o[1]); w.y = cvt_pk_bf16(o[2], o[3]); w.z = cvt_pk_bf16(o[4], o[5]); w.w = cvt_pk_bf16(o[6], o[7]);
                __builtin_nontemporal_store(w, (u32x4*)(H + (size_t)(row0 + ai * HALF + m * 16) * ldh + col0)); }
    }
};

template <class Epi, bool ALIGN_EPI, bool FP8 = false, bool BR3 = false>
__device__ __forceinline__ void gemm_phase(LAS unsigned char* lds, const Gemm g, const StaticOrder& S, const Epi& E) {
    const int tid = opq_tid(), wid = __builtin_amdgcn_readfirstlane(tid >> 6), lane = tid & 63, wr = wid >> 2, wc = wid & 3, fr = lane & 15, fq = lane >> 4;
    constexpr int ESZ = FP8 ? 1 : 2;
    const int K = g.K; int nt = K * ESZ / (BK * 2);
#define PG8_KOFF(u) (BR3 ? ((u).br == 0 ? 0 : ((u).br == 1 ? 1024 : 2560)) : 0)
#define PG8_NT(u) (BR3 ? ((u).br == 0 ? 8 : 12) : nt)
    unsigned voffA[2], voffB[2];
#pragma unroll
    for (int i = 0; i < 2; ++i) { int R, C; if constexpr (FP8) stage_rc8(tid * 16 + i * 8192, R, C); else { stage_rc(tid * 16 + i * 8192, R, C); C *= 2; }
        const int Rb = Epi::PERM ? ((R & ~31) + perm32(R & 31)) : R;
        voffA[i] = (unsigned)(R * g.lda * ESZ + C); voffB[i] = (unsigned)(Rb * g.ldb * ESZ + C); }
    const size_t kstep = (size_t)(BK * 2);
    const size_t hstepA = (size_t)HALF * g.lda * ESZ, hstepB = (size_t)HALF * g.ldb * ESZ;
    const size_t tstepA = 2 * hstepA, tstepB = 2 * hstepB;
    const unsigned ldsw = (unsigned)wid * 1024u;
    const int aoff = FP8 ? wr * 8192 + lane * 32 : lds_byte(wr * 64 + fr, fq * 8), boff = FP8 ? wc * 4096 + lane * 32 : lds_byte(wc * 32 + fr, fq * 8);
    LAS float* rsl = (LAS float*)(lds + STAGE_BYTES);
#define PG8_SA(b, h) (((b) * 2 + (h)) * HTB)
#define PG8_SB(b, h) ((4 + (b) * 2 + (h)) * HTB)
#define PG8_STAGE(bufoff, gbase, voff) do { _Pragma("unroll") for (int _i = 0; _i < 2; ++_i) \
        __builtin_amdgcn_global_load_lds((const unsigned*)((const char*)(gbase) + (voff)[_i]), (LAS unsigned*)(lds + (bufoff) + ldsw + _i * 8192), 16, 0, 0); } while (0)
#define PG8_LDA(dst, b, h) do { _Pragma("unroll") for (int m = 0; m < 4; ++m) { if constexpr (FP8) { const v4i_t lo_ = *(const LAS v4i_t*)(lds + PG8_SA(b, h) + aoff + m * 2048), hi_ = *(const LAS v4i_t*)(lds + PG8_SA(b, h) + aoff + m * 2048 + 16); dst##8[m] = __builtin_shufflevector(lo_, hi_, 0, 1, 2, 3, 4, 5, 6, 7); } \
        else { _Pragma("unroll") for (int k = 0; k < 2; ++k) dst[m][k] = *(const LAS bf16x8*)(lds + PG8_SA(b, h) + aoff + m * 2048 + k * 1024); } } } while (0)
#define PG8_LDB(dst, b, h) do { _Pragma("unroll") for (int n = 0; n < 2; ++n) { if constexpr (FP8) { const v4i_t lo_ = *(const LAS v4i_t*)(lds + PG8_SB(b, h) + boff + n * 2048), hi_ = *(const LAS v4i_t*)(lds + PG8_SB(b, h) + boff + n * 2048 + 16); dst##8[n] = __builtin_shufflevector(lo_, hi_, 0, 1, 2, 3, 4, 5, 6, 7); } \
        else { _Pragma("unroll") for (int k = 0; k < 2; ++k) dst[n][k] = *(const LAS bf16x8*)(lds + PG8_SB(b, h) + boff + n * 2048 + k * 1024); } } } while (0)
#define PG8_MMA(ai, bj, At, Bt) do { __builtin_amdgcn_s_setprio(1); _Pragma("unroll") for (int m = 0; m < 4; ++m) _Pragma("unroll") for (int n = 0; n < 2; ++n) { \
        if constexpr (FP8) asm volatile("v_mfma_f32_16x16x128_f8f6f4 %0, %1, %2, %0" : "+v"(acc[ai][bj][m][n]) : "v"(Bt##8[n]), "v"(At##8[m]));   \
        else { _Pragma("unroll") for (int k = 0; k < 2; ++k) acc[ai][bj][m][n] = __builtin_amdgcn_mfma_f32_16x16x32_bf16(Bt[n][k], At[m][k], acc[ai][bj][m][n], 0, 0, 0); } } __builtin_amdgcn_s_setprio(0); } while (0)
#define PG8_WAIT_V(n) asm volatile("s_waitcnt vmcnt(" #n ")" ::: "memory")
#define PG8_WAIT_L(n) asm volatile("s_waitcnt lgkmcnt(" #n ")" ::: "memory")
#define PG8_BAR __builtin_amdgcn_s_barrier()
#define PG8_SCHED __builtin_amdgcn_sched_barrier(0)
    Unit cur, nxt; int ui = 0;
    if (!S.next(0, cur)) return;
    f32x4 acc[2][2][4][2];
#pragma unroll
    for (int a = 0; a < 2; ++a)
#pragma unroll
        for (int b = 0; b < 2; ++b)
#pragma unroll
            for (int m = 0; m < 4; ++m)
#pragma unroll
                for (int n = 0; n < 2; ++n) acc[a][b][m][n] = (f32x4){0.f, 0.f, 0.f, 0.f};
    bf16x8 At[4][2], B0[2][2], B1[2][2];
    v8i_t At8[4], B08[2], B18[2];
    const char* cA = (const char*)g.A + (size_t)cur.pm * tstepA + PG8_KOFF(cur); const char* cB = (const char*)g.Bt + (size_t)cur.pn * tstepB + PG8_KOFF(cur);
    PG8_STAGE(PG8_SB(0, 0), cB, voffB); PG8_STAGE(PG8_SB(0, 1), cB + hstepB, voffB); PG8_STAGE(PG8_SA(0, 0), cA, voffA); PG8_STAGE(PG8_SA(0, 1), cA + hstepA, voffA);
    if (wr == 1) PG8_BAR;
    PG8_WAIT_V(2); PG8_BAR;
    PG8_STAGE(PG8_SB(1, 0), cB + kstep, voffB); PG8_STAGE(PG8_SA(1, 0), cA + kstep, voffA); PG8_STAGE(PG8_SB(1, 1), cB + hstepB + kstep, voffB);
    PG8_WAIT_V(6); PG8_BAR;
    for (;;) {
        const bool has_next = S.next(ui + 1, nxt);
        rs_t rv = 0; if constexpr (Epi::ROWSCALE) { const rs_t* rp = E.rs + cur.pm * BM + (tid & 255); asm volatile("global_load_dwordx2 %0, %1, off" : "=v"(rv) : "v"(rp) : "memory"); }
        const char* nA = has_next ? (const char*)g.A + (size_t)nxt.pm * tstepA + PG8_KOFF(nxt) : cA; const char* nB = has_next ? (const char*)g.Bt + (size_t)nxt.pn * tstepB + PG8_KOFF(nxt) : cB;
        nt = PG8_NT(cur);
        for (int t = 0; t < nt; t += 2) {
            const bool last = (t == nt - 2);
            const char* a1 = cA + (size_t)(t + 1) * kstep;
            const char* a2 = last ? nA : cA + (size_t)(t + 2) * kstep; const char* b2 = last ? nB : cB + (size_t)(t + 2) * kstep;
            const char* a3 = a2 + kstep; const char* b3 = b2 + kstep;
            PG8_LDB(B0, 0, 0); PG8_LDB(B1, 0, 1); PG8_SCHED; PG8_LDA(At, 0, 0); PG8_STAGE(PG8_SA(1, 1), a1 + hstepA, voffA);
            PG8_WAIT_V(8); PG8_WAIT_L(0); PG8_BAR; PG8_MMA(0, 0, At, B0); PG8_MMA(0, 1, At, B1); PG8_BAR; PG8_SCHED;
            PG8_LDA(At, 0, 1); PG8_STAGE(PG8_SB(0, 0), b2, voffB); PG8_STAGE(PG8_SB(0, 1), b2 + hstepB, voffB); PG8_STAGE(PG8_SA(0, 0), a2, voffA);
            PG8_WAIT_V(8); PG8_WAIT_L(0); PG8_BAR; PG8_MMA(1, 0, At, B0); PG8_MMA(1, 1, At, B1); PG8_BAR; PG8_SCHED;
            PG8_LDB(B0, 1, 0); PG8_LDB(B1, 1, 1); PG8_SCHED; PG8_LDA(At, 1, 0); PG8_STAGE(PG8_SA(0, 1), a2 + hstepA, voffA);
            PG8_WAIT_V(8); PG8_WAIT_L(0); PG8_BAR; PG8_MMA(0, 0, At, B0); PG8_MMA(0, 1, At, B1); PG8_BAR; PG8_SCHED;
            PG8_LDA(At, 1, 1); PG8_STAGE(PG8_SB(1, 0), b3, voffB); PG8_STAGE(PG8_SB(1, 1), b3 + hstepB, voffB); PG8_STAGE(PG8_SA(1, 0), a3, voffA);
            PG8_WAIT_V(8); PG8_WAIT_L(0); PG8_BAR; PG8_MMA(1, 0, At, B0); PG8_MMA(1, 1, At, B1); PG8_BAR; PG8_SCHED;
        }
        if constexpr (FP8) asm volatile("s_nop 7\n\ts_nop 7\n\ts_nop 7" ::: "memory");
        if constexpr (ALIGN_EPI) { if (wr == 0) PG8_BAR; }
        if constexpr (Epi::ROWSCALE) {
            static_assert(ALIGN_EPI, "row-scale table needs the aligned epilogue");
            asm volatile("s_waitcnt vmcnt(0)" : "+v"(rv) :: "memory");
            if (tid < 256) rsl[tid] = 1.0f / sqrtf((float)rv * (RS_INV / D) + EPS);
            PG8_WAIT_L(0); PG8_BAR; }
        E(acc, cur, wr, wc, fr, fq, rsl);
        if (!has_next) break;
        if (!BR3 || cur.br == 2) {
#pragma unroll
        for (int a = 0; a < 2; ++a)
#pragma unroll
            for (int b = 0; b < 2; ++b)
#pragma unroll
                for (int m = 0; m < 4; ++m)
#pragma unroll
                    for (int n = 0; n < 2; ++n) acc[a][b][m][n] = (f32x4){0.f, 0.f, 0.f, 0.f};
        }
        cur = nxt; cA = nA; cB = nB; ++ui;
        if constexpr (ALIGN_EPI) { if (wr == 1) PG8_BAR; }
    }
    PG8_WAIT_V(0);
    if constexpr (!ALIGN_EPI) { if (wr == 0) PG8_BAR; }
    PG8_BAR;
#undef PG8_SA
#undef PG8_SB
#undef PG8_STAGE
#undef PG8_LDA
#undef PG8_LDB
#undef PG8_MMA
#undef PG8_KOFF
#undef PG8_NT
#undef PG8_WAIT_V
#undef PG8_WAIT_L
#undef PG8_BAR
#undef PG8_SCHED
}
}

#define XB_TMO      128
#define XB_XCNT(j)  (256  + 64 * (j))
#define XB_XSUB(j)  (1280 + 64 * (j))
#define XB_XGEN(j)  (2304 + 64 * (j))
#define XB_TOP      3328
#define XB_TOPGEN   3392
#define XCD_BAR_WORDS 3456
#define XB_SPIN_CAP (1u << 18)
__device__ __forceinline__ unsigned xb_ld(unsigned* p)              { return __hip_atomic_load(p, __ATOMIC_RELAXED, __HIP_MEMORY_SCOPE_AGENT); }
__device__ __forceinline__ unsigned xb_add(unsigned* p, unsigned v) { return __hip_atomic_fetch_add(p, v, __ATOMIC_RELAXED, __HIP_MEMORY_SCOPE_AGENT); }
__device__ __forceinline__ unsigned xb_xcc_id() { return (unsigned)__builtin_amdgcn_s_getreg((3 << 11) | 20) & 0xFu; }
#define XB_SPIN(cond, bar) do { unsigned _sp = 0; while (cond) { __builtin_amdgcn_s_sleep(1); \
    if ((++_sp & 255u) == 0u) { if (xb_ld(&(bar)[XB_TMO])) break; if (_sp > XB_SPIN_CAP) { atomicAdd(&(bar)[XB_TMO], 1u); break; } } } } while (0)
struct XcdBarrier { unsigned* bar; unsigned x; volatile LAS unsigned* st; };
__device__ __forceinline__ XcdBarrier xcd_barrier_post(unsigned* bar, volatile LAS unsigned* st) {
    XcdBarrier b; b.bar = bar; b.x = xb_xcc_id(); b.st = st;
    if (threadIdx.x == 0) (void)xb_add(&bar[XB_XCNT(b.x)], 1u);
    return b;
}
__device__ __forceinline__ void xcd_barrier_complete(unsigned* bar, unsigned x, unsigned& nloc, unsigned& nx) {
    const unsigned G = gridDim.x * gridDim.y * gridDim.z;
    unsigned sum, cnt, mine, sp = 0u;
    for (;;) {
        sum = 0u; cnt = 0u; mine = 0u;
#pragma unroll
        for (unsigned j = 0; j < 16; ++j) { const unsigned c = xb_ld(&bar[XB_XCNT(j)]); sum += c; cnt += (c > 0u) ? 1u : 0u; mine = (j == x) ? c : mine; }
        if (sum == G) break;
        __builtin_amdgcn_s_sleep(1);
        if ((++sp & 255u) == 0u) { if (xb_ld(&bar[XB_TMO])) break; if (sp > XB_SPIN_CAP) { atomicAdd(&bar[XB_TMO], 1u); break; } }
    }
    nloc = mine > 0u ? mine : 1u; nx = cnt > 0u ? cnt : 1u;
}
__device__ __forceinline__ void xcd_barrier(const XcdBarrier& b) {
    asm volatile("s_waitcnt vmcnt(0)" ::: "memory");
    __syncthreads();
    if (threadIdx.x == 0) {
        unsigned* bar = b.bar;
        __builtin_amdgcn_s_waitcnt(0);
        unsigned nloc = b.st[0], nx = b.st[1];
        if (nloc == 0u) { xcd_barrier_complete(bar, b.x, nloc, nx); b.st[0] = nloc; b.st[1] = nx; }
        const unsigned old = xb_add(&bar[XB_XSUB(b.x)], 1u);
        const unsigned gen = old / nloc;
        if (old + 1u == (gen + 1u) * nloc) {
            __builtin_amdgcn_fence(__ATOMIC_RELEASE, "agent");
            asm volatile("s_waitcnt vmcnt(0)" ::: "memory");
            const unsigned og = xb_add(&bar[XB_TOP], 1u);
            const unsigned tg = og / nx;
            if (og + 1u == (tg + 1u) * nx) xb_add(&bar[XB_TOPGEN], 1u);
            else XB_SPIN(xb_ld(&bar[XB_TOPGEN]) == tg, bar);
            __builtin_amdgcn_fence(__ATOMIC_ACQUIRE, "agent");
            xb_add(&bar[XB_XGEN(b.x)], 1u);
            asm volatile("s_waitcnt vmcnt(0)" ::: "memory");
        } else {
            XB_SPIN(xb_ld(&bar[XB_XGEN(b.x)]) == gen, bar);
            __builtin_amdgcn_fence(__ATOMIC_ACQUIRE, "agent");
            asm volatile("s_waitcnt vmcnt(0)" ::: "memory");
        }
    }
    __syncthreads();
}

constexpr int RING_BYTES = 131072;
constexpr int LDS_MISC = RING_BYTES + 2048;
constexpr int LDS_BYTES = 147456;
struct Args {
    const float* in[18]; float* out; unsigned char* ws;
    int l_lo, l_hi, ph_lo, ph_hi;
};
struct Frame {
    LAS unsigned char* lds;
    int G, bid;
};
typedef const __attribute__((address_space(4))) Args* KArgsP;
__device__ __forceinline__ KArgsP kargs() { KArgsP p = (KArgsP)__builtin_amdgcn_kernarg_segment_ptr(); asm volatile("" : "+s"(p)); return p; }
#define A_IN(i) (kargs()->in[i])
#define A_WS(T, off) ((T*)(kargs()->ws + (off)))
#define A_OUT (kargs()->out)
#define P_x A_IN(0)
#define P_rel_bias A_IN(1)
#define P_norm1_g A_IN(2)
#define P_w_in A_IN(3)
#define P_q_norm_g A_IN(4)
#define P_k_norm_g A_IN(5)
#define P_gla_gate_up A_IN(6)
#define P_gla_gate_b A_IN(7)
#define P_gla_out_g A_IN(8)
#define P_sgu_ln_g A_IN(9)
#define P_sgu_ln_b A_IN(10)
#define P_sgu_w A_IN(11)
#define P_sgu_b A_IN(12)
#define P_w_branch A_IN(13)
#define P_w_out A_IN(14)
#define P_norm2_g A_IN(15)
#define P_w_ffn_in A_IN(16)
#define P_w_ffn_out A_IN(17)
#define P_WIN A_WS(bf16_t, WS_WIN)
#define P_W8 A_WS(unsigned char, WS_W8)
#define P_XB8 A_WS(unsigned char, WS_XB8)
#define P_WBR A_WS(bf16_t, WS_WBR)
#define P_WO A_WS(bf16_t, WS_WO)
#define P_WFI A_WS(bf16_t, WS_WFI)
#define P_WFO A_WS(bf16_t, WS_WFO)
#define P_XN A_WS(bf16_t, WS_XN)
#define P_Y A_WS(bf16_t, WS_Y)
#define P_OMIX A_WS(bf16_t, WS_OMIX)
#define P_Z A_WS(bf16_t, WS_Z)
#define P_H A_WS(bf16_t, WS_Z)
#define P_SP A_WS(bf16_t, WS_SP)
#define P_QT A_WS(bf16_t, WS_QT)
#define P_KT A_WS(bf16_t, WS_KT)
#define P_AO ((bf16_t*)((unsigned char*)A_OUT + OUT_AO))
#define P_SL ((bf16_t*)((unsigned char*)A_OUT + OUT_SL))
#define P_DL A_WS(float, WS_DL)
#define P_LSE A_WS(float, WS_LSE)
#define P_out A_OUT
#define P_RS1 A_WS(rs_t, WS_RS1)
#define P_RS2 A_WS(rs_t, WS_RS2)

template <bool FP8OUT, class SrcCol>
__device__ __forceinline__ void transpose_item(const float* W, int ldw, void* WTv, int K, LAS float* scr, int item, int nblk, int lane, const float* gain, SrcCol srccol) {
    const int kb = item / nblk, nb = item % nblk, k0 = 64 * kb, n0 = 32 * nb;
    const int nq = lane & 7, kr = lane >> 3, sc = srccol(n0 + 4 * nq);
    f32x4 v[8]; float gk[8];
#pragma unroll
    for (int i = 0; i < 8; ++i) { const int kk = 8 * i + kr; v[i] = sc >= 0 ? *(const f32x4*)(W + (size_t)(k0 + kk) * ldw + sc) : (f32x4){0.f, 0.f, 0.f, 0.f}; gk[i] = gain ? gain[k0 + kk] : 1.0f; }
#pragma unroll
    for (int i = 0; i < 8; ++i) { const int kk = 8 * i + kr; LAS float* d = scr + kk * 33 + 4 * nq; d[0] = v[i].x * gk[i]; d[1] = v[i].y * gk[i]; d[2] = v[i].z * gk[i]; d[3] = v[i].w * gk[i]; }
    LDS_WAIT(); asm volatile("" ::: "memory");
    const int c = lane & 7;
#pragma unroll
    for (int j = 0; j < 4; ++j) { const int n = (lane >> 3) + 8 * j; const LAS float* s = scr + (8 * c) * 33 + n;
        if constexpr (FP8OUT) { u32x2 o; o.x = 0u; o.y = 0u;
            o.x = __builtin_amdgcn_cvt_pk_fp8_f32(s[0 * 33] * W8_SCALE, s[1 * 33] * W8_SCALE, o.x, false); o.x = __builtin_amdgcn_cvt_pk_fp8_f32(s[2 * 33] * W8_SCALE, s[3 * 33] * W8_SCALE, o.x, true);
            o.y = __builtin_amdgcn_cvt_pk_fp8_f32(s[4 * 33] * W8_SCALE, s[5 * 33] * W8_SCALE, o.y, false); o.y = __builtin_amdgcn_cvt_pk_fp8_f32(s[6 * 33] * W8_SCALE, s[7 * 33] * W8_SCALE, o.y, true);
            *(u32x2*)((unsigned char*)WTv + (size_t)(n0 + n) * K + k0 + 8 * c) = o; }
        else { u32x4 o; o.x = cvt_pk_bf16(s[0 * 33], s[1 * 33]); o.y = cvt_pk_bf16(s[2 * 33], s[3 * 33]); o.z = cvt_pk_bf16(s[4 * 33], s[5 * 33]); o.w = cvt_pk_bf16(s[6 * 33], s[7 * 33]);
            *(u32x4*)((bf16_t*)WTv + (size_t)(n0 + n) * K + k0 + 8 * c) = o; } }
    LDS_WAIT(); asm volatile("" ::: "memory");
}
__device__ __forceinline__ void cast_rows(Frame& F, const float* x, bf16_t* xb, rs_t* rs, unsigned char* xb8) {
    const int tid_ = opq_tid(), lane = tid_ & 63, wave = __builtin_amdgcn_readfirstlane(tid_ >> 6);
    const int gw = F.bid * NWAVES + wave, NGW = F.G * NWAVES;
    for (int m = gw; m < M; m += NGW) {
        const f32x4* xr = (const f32x4*)(x + (size_t)m * D) + lane;
        f32x4 v[8]; float s = 0.f;
#pragma unroll
        for (int j = 0; j < 8; ++j) { v[j] = xr[64 * j]; s += (v[j].x * v[j].x + v[j].y * v[j].y) + (v[j].z * v[j].z + v[j].w * v[j].w); }
        s = wave_sum(s);
        u32x2* o8 = (u32x2*)(xb + (size_t)m * D) + lane;
#pragma unroll
        for (int j = 0; j < 8; ++j) { u32x2 w; w.x = cvt_pk_bf16(v[j].x, v[j].y); w.y = cvt_pk_bf16(v[j].z, v[j].w); o8[64 * j] = w; }
        unsigned* o4 = (unsigned*)(xb8 + (size_t)m * D) + lane;
#pragma unroll
        for (int j = 0; j < 8; ++j) { unsigned q8 = 0u; q8 = __builtin_amdgcn_cvt_pk_fp8_f32(v[j].x, v[j].y, q8, false); q8 = __builtin_amdgcn_cvt_pk_fp8_f32(v[j].z, v[j].w, q8, true); o4[64 * j] = q8; }
        if (lane == 0) rs[m] = (rs_t)(s * RS_SCALE + 0.5f);
    }
}
struct TJob { const float* src; const float* gp; unsigned char* dst; int ldw, K; bool valid, fp8; };
__device__ __forceinline__ void tj_load(const TJob& j, f32x4 (&v)[8], float (&gk)[8]) {
#pragma unroll
    for (int i = 0; i < 8; ++i) { v[i] = j.valid ? *(const f32x4*)(j.src + (size_t)(8 * i) * j.ldw) : (f32x4){0.f, 0.f, 0.f, 0.f}; gk[i] = j.gp ? j.gp[8 * i] : 1.0f; }
}
__device__ __forceinline__ void tj_process(const TJob& j, const f32x4 (&v)[8], const float (&gk)[8], LAS float* scr, int lane) {
    const int nq = lane & 7, kr = lane >> 3;
#pragma unroll
    for (int i = 0; i < 8; ++i) { const int kk = 8 * i + kr; LAS float* d = scr + kk * 33 + 4 * nq; d[0] = v[i].x * gk[i]; d[1] = v[i].y * gk[i]; d[2] = v[i].z * gk[i]; d[3] = v[i].w * gk[i]; }
    LDS_WAIT(); asm volatile("" ::: "memory");
    const int c = lane & 7;
#pragma unroll
    for (int q = 0; q < 4; ++q) { const int n = (lane >> 3) + 8 * q; const LAS float* s = scr + (8 * c) * 33 + n;
        if (j.fp8) { u32x2 o; o.x = 0u; o.y = 0u;
            o.x = __builtin_amdgcn_cvt_pk_fp8_f32(s[0 * 33] * W8_SCALE, s[1 * 33] * W8_SCALE, o.x, false); o.x = __builtin_amdgcn_cvt_pk_fp8_f32(s[2 * 33] * W8_SCALE, s[3 * 33] * W8_SCALE, o.x, true);
            o.y = __builtin_amdgcn_cvt_pk_fp8_f32(s[4 * 33] * W8_SCALE, s[5 * 33] * W8_SCALE, o.y, false); o.y = __builtin_amdgcn_cvt_pk_fp8_f32(s[6 * 33] * W8_SCALE, s[7 * 33] * W8_SCALE, o.y, true);
            *(u32x2*)(j.dst + (size_t)(8 * q) * j.K) = o; }
        else { u32x4 o; o.x = cvt_pk_bf16(s[0 * 33], s[1 * 33]); o.y = cvt_pk_bf16(s[2 * 33], s[3 * 33]); o.z = cvt_pk_bf16(s[4 * 33], s[5 * 33]); o.w = cvt_pk_bf16(s[6 * 33], s[7 * 33]);
            *(u32x4*)(j.dst + (size_t)(16 * q) * j.K) = o; } }
    LDS_WAIT(); asm volatile("" ::: "memory");
}
__device__ __forceinline__ void p0_convert(Frame& F, int l) {
    const int tid_ = opq_tid(), lane = tid_ & 63, wave = __builtin_amdgcn_readfirstlane(tid_ >> 6);
    LAS float* scr = (LAS float*)(F.lds + wave * 16384);
    const int gw = F.bid * NWAVES + wave, NGW = F.G * NWAVES;
    constexpr int I_IN = (D / 64) * (NB / 32), I_8 = (D / 64) * (N8 / 32), I_BR = (D / 64) * (D / 32), I_O = I_BR, I_FI = (D / 64) * (NFI / 32), I_FO = (DFF / 64) * (D / 32);
    constexpr int NITEMS = I_IN + I_8 + I_BR + I_O + I_FI + I_FO;
    const int nq = lane & 7, kr = lane >> 3;
    auto describe = [&](int it) -> TJob {
        const float* w_in = P_w_in + (size_t)l * D * DIN; const float* w_br = P_w_branch + (size_t)l * D * D; const float* w_o = P_w_out + (size_t)l * D * D;
        const float* w_fi = P_w_ffn_in + (size_t)l * D * NFI; const float* w_fo = P_w_ffn_out + (size_t)l * DFF * D;
        auto fin = [&](const float* W, int ldw, void* WT, int K, int kb, int nb, const float* gain, int sc, bool fp8) -> TJob {
            TJob j; const int k0 = 64 * kb, n0 = 32 * nb;
            j.src = W + (size_t)(k0 + kr) * ldw + sc; j.gp = gain ? gain + k0 + kr : nullptr; j.ldw = ldw; j.K = K; j.valid = sc >= 0; j.fp8 = fp8;
            j.dst = (unsigned char*)WT + ((size_t)(n0 + (lane >> 3)) * K + k0 + 8 * (lane & 7)) * (fp8 ? 1 : 2); return j; };
        int r = it;
        if (r < I_IN) { const int nb = r % (NB / 32), n = 32 * nb + 4 * nq;
            return fin(w_in, DIN, P_WIN, D, r / (NB / 32), nb, P_norm1_g + l * D, n < 1536 ? 4608 + n : (n < 3072 ? 6160 + (n - 1536) : (n < 3088 ? 6144 + (n - 3072) : -1)), false); } r -= I_IN;
        if (r < I_8) { const int nb = r % (N8 / 32), n = 32 * nb + 4 * nq;
            return fin(w_in, DIN, P_W8, D, r / (N8 / 32), nb, P_norm1_g + l * D, n < 4608 ? n : 7696 + (n - 4608), true); } r -= I_8;
        if (r < I_BR) { const int nb = r % (D / 32); return fin(w_br, D, P_WBR, D, r / (D / 32), nb, nullptr, 32 * nb + 4 * nq, false); } r -= I_BR;
        if (r < I_O) { const int nb = r % (D / 32); return fin(w_o, D, P_WO, D, r / (D / 32), nb, nullptr, 32 * nb + 4 * nq, false); } r -= I_O;
        if (r < I_FI) { const int nb = r % (NFI / 32), n = 32 * nb + 4 * nq, t = n >> 8, jj = n & 255;
            return fin(w_fi, NFI, P_WFI, D, r / (NFI / 32), nb, P_norm2_g + l * D, jj < 128 ? 128 * t + jj : DFF + 128 * t + (jj - 128), false); } r -= I_FI;
        { const int nb = r % (D / 32); return fin(w_fo, D, P_WFO, DFF, r / (D / 32), nb, nullptr, 32 * nb + 4 * nq, false); }
    };
    f32x4 vA[8], vB[8]; float gA[8], gB[8]; TJob jA, jB;
    int it = gw;
    if (it < NITEMS) { jA = describe(it); tj_load(jA, vA, gA); }
    for (; it < NITEMS; it += 2 * NGW) {
        const bool hasB = it + NGW < NITEMS;
        if (hasB) { jB = describe(it + NGW); tj_load(jB, vB, gB); }
        tj_process(jA, vA, gA, scr, lane);
        if (it + 2 * NGW < NITEMS) { jA = describe(it + 2 * NGW); tj_load(jA, vA, gA); }
        if (hasB) tj_process(jB, vB, gB, scr, lane);
    }
}

__device__ __forceinline__ unsigned off_b(unsigned row, unsigned ch) { return 256u * row + 16u * (ch ^ (((row & 3u) << 2) | ((row >> 2) & 3u))); }
__device__ __forceinline__ s16x4 tr16(const LAS unsigned char* p) {
    typedef short v4i16_t __attribute__((ext_vector_type(4)));
    return __builtin_bit_cast(s16x4, __builtin_amdgcn_ds_read_tr16_b64_v4i16((LAS v4i16_t*)p));
}
__device__ __forceinline__ bf16x8 cat8(s16x4 a, s16x4 b) { return (bf16x8){a[0], a[1], a[2], a[3], b[0], b[1], b[2], b[3]}; }
__device__ __forceinline__ int t5_bucket(int td) {
    if (td < 16) return td;
    int b = 16;
    b += td >= 22; b += td >= 30; b += td >= 40; b += td >= 54; b += td >= 73; b += td >= 99; b += td >= 134; b += td >= 182;
    b += td >= 246; b += td >= 332; b += td >= 450; b += td >= 609; b += td >= 825; b += td >= 1117; b += td >= 1513;
    return b;
}
constexpr int ATT_K = 0, ATT_V = 65536, ATT_BIAS = 131072;
__device__ __forceinline__ void attn_norm_store(LAS unsigned char* Kimg, LAS unsigned char* Vimg, int row, int ch, u32x4 kv, u32x4 vv, f32x4 gk0, f32x4 gk1) {
    float kf[8] = {bflo(kv.x), bfhi(kv.x), bflo(kv.y), bfhi(kv.y), bflo(kv.z), bfhi(kv.z), bflo(kv.w), bfhi(kv.w)};
    float ss = 0.f;
#pragma unroll
    for (int j = 0; j < 8; ++j) ss += kf[j] * kf[j];
    ss += __shfl_xor(ss, 1); ss += __shfl_xor(ss, 2); ss += __shfl_xor(ss, 4); ss += __shfl_xor(ss, 8);
    const float rs = 1.0f / sqrtf(ss * (1.f / 128.f) + EPS);
    u32x4 ko; ko.x = cvt_pk_bf16(kf[0] * rs * gk0.x, kf[1] * rs * gk0.y); ko.y = cvt_pk_bf16(kf[2] * rs * gk0.z, kf[3] * rs * gk0.w);
    ko.z = cvt_pk_bf16(kf[4] * rs * gk1.x, kf[5] * rs * gk1.y); ko.w = cvt_pk_bf16(kf[6] * rs * gk1.z, kf[7] * rs * gk1.w);
    const unsigned o = off_b((unsigned)row, (unsigned)ch);
    *(LAS u32x4*)(Kimg + o) = ko; *(LAS u32x4*)(Vimg + o) = vv;
}
__device__ __forceinline__ void attn_seg(Frame& F, int seg, int l) {
    const int rnb = seg & 7, h = (seg >> 3) & 3, bg = seg >> 5, g = bg % 3, b = bg / 3;
    const int dsh = 2 * g, dil = 1 << dsh, nb = 32 >> dsh;
    const bf16_t* Zb = P_Z + (size_t)b * SEQ * NZ;
    const int qcol = g * 512 + h * 128;
    LAS unsigned char* Kimg = F.lds + ATT_K; LAS unsigned char* Vimg = F.lds + ATT_V; LAS float* biasT = (LAS float*)(F.lds + ATT_BIAS);
    const int tid = opq_tid(), lane = tid & 63, w = __builtin_amdgcn_readfirstlane(tid >> 6), fr = lane & 15, fq = lane >> 4;
    if (tid < 192) { const int d = tid - 32; biasT[tid] = (d >= 0 && d <= 128) ? P_rel_bias[t5_bucket(d << dsh) * 12 + g * 4 + h] : -3.0e38f; }
    LAS float* gqL = biasT + 256;
    if (tid >= 256 && tid < 384) gqL[tid - 256] = P_q_norm_g[l * 128 + (tid - 256)];
    const int ch = tid & 15, srow = tid >> 4;
    const f32x4 gk0 = *(const f32x4*)(P_k_norm_g + l * 128 + ch * 8), gk1 = *(const f32x4*)(P_k_norm_g + l * 128 + ch * 8 + 4);
    u32x4 kc[4], vc[4];
    {
        const int rn = 4 * rnb, r = rn / nb, n = rn % nb;
#pragma unroll
        for (int it = 0; it < 4; ++it) { const bf16_t* p = Zb + (size_t)((128 * n + it * 32 + srow) * dil + r) * NZ + qcol + ch * 8; kc[it] = *(const u32x4*)(p + ZK); vc[it] = *(const u32x4*)(p + ZV); }
    }
#pragma unroll 1
    for (int pos = 0; pos < 4; ++pos) {
        const int rn = 4 * rnb + pos, r = rn / nb, n = rn % nb;
        const int cs = (n & 1) << 7, ps = cs ^ 128;
        const int qi = 16 * w + fr, qtok = (128 * n + qi) * dil + r;
        const size_t qrow = (size_t)b * SEQ + qtok;
        u32x4 qv[4];
        { const bf16_t* qp = P_Z + qrow * NZ + ZQ + qcol + 8 * fq;
#pragma unroll
          for (int ks = 0; ks < 4; ++ks) qv[ks] = *(const u32x4*)(qp + 32 * ks); }
        if (n == 0) {
#pragma unroll
            for (int it = 0; it < 4; ++it) { const unsigned o = off_b((unsigned)(ps + it * 32 + srow), (unsigned)ch); *(LAS u32x4*)(Kimg + o) = (u32x4){0u, 0u, 0u, 0u}; *(LAS u32x4*)(Vimg + o) = (u32x4){0u, 0u, 0u, 0u}; }
        } else if (pos == 0) {
            u32x4 kp[4], vp[4];
#pragma unroll
            for (int it = 0; it < 4; ++it) { const bf16_t* p = Zb + (size_t)((128 * (n - 1) + it * 32 + srow) * dil + r) * NZ + qcol + ch * 8; kp[it] = *(const u32x4*)(p + ZK); vp[it] = *(const u32x4*)(p + ZV); }
#pragma unroll
            for (int it = 0; it < 4; ++it) attn_norm_store(Kimg, Vimg, ps + it * 32 + srow, ch, kp[it], vp[it], gk0, gk1);
        }
#pragma unroll
        for (int it = 0; it < 4; ++it) attn_norm_store(Kimg, Vimg, cs + it * 32 + srow, ch, kc[it], vc[it], gk0, gk1);
        if (pos < 3) {
            const int rn2 = rn + 1, r2 = rn2 / nb, n2 = rn2 % nb;
#pragma unroll
            for (int it = 0; it < 4; ++it) { const bf16_t* p = Zb + (size_t)((128 * n2 + it * 32 + srow) * dil + r2) * NZ + qcol + ch * 8; kc[it] = *(const u32x4*)(p + ZK); vc[it] = *(const u32x4*)(p + ZV); }
        }
        bf16x8 qf[4];
        {
            float ss = 0.f;
#pragma unroll
            for (int ks = 0; ks < 4; ++ks) {
                const float a0 = bflo(qv[ks].x), a1 = bfhi(qv[ks].x), a2 = bflo(qv[ks].y), a3 = bfhi(qv[ks].y), a4 = bflo(qv[ks].z), a5 = bfhi(qv[ks].z), a6 = bflo(qv[ks].w), a7 = bfhi(qv[ks].w);
                ss += (a0 * a0 + a1 * a1) + (a2 * a2 + a3 * a3) + (a4 * a4 + a5 * a5) + (a6 * a6 + a7 * a7); }
            ss += __shfl_xor(ss, 16); ss += __shfl_xor(ss, 32);
            const float rs = (1.0f / sqrtf(ss * (1.f / 128.f) + EPS)) * 0.08838834764831845f;
#pragma unroll
            for (int ks = 0; ks < 4; ++ks) { const f32x4 g0 = *(const LAS f32x4*)(gqL + 32 * ks + 8 * fq), g1 = *(const LAS f32x4*)(gqL + 32 * ks + 8 * fq + 4);
                u32x4 o; o.x = cvt_pk_bf16(bflo(qv[ks].x) * rs * g0.x, bfhi(qv[ks].x) * rs * g0.y); o.y = cvt_pk_bf16(bflo(qv[ks].y) * rs * g0.z, bfhi(qv[ks].y) * rs * g0.w);
                o.z = cvt_pk_bf16(bflo(qv[ks].z) * rs * g1.x, bfhi(qv[ks].z) * rs * g1.y); o.w = cvt_pk_bf16(bflo(qv[ks].w) * rs * g1.z, bfhi(qv[ks].w) * rs * g1.w);
                qf[ks] = __builtin_bit_cast(bf16x8, o); }
        }
        WG_SYNC();
        const int kb0 = w >> 1;
        f32x4 s[5][2];
#pragma unroll
        for (int kbi = 0; kbi < 5; ++kbi)
#pragma unroll
            for (int hb = 0; hb < 2; ++hb) {
                const unsigned krow = (unsigned)((32 * (kb0 + kbi) + 8 * (fr >> 2) + (fr & 3) + 4 * hb) ^ ps);
                f32x4 a = (f32x4){0.f, 0.f, 0.f, 0.f};
#pragma unroll
                for (int ks = 0; ks < 4; ++ks) { const bf16x8 kfr = *(const LAS bf16x8*)(Kimg + off_b(krow, (unsigned)(4 * ks + fq))); a = __builtin_amdgcn_mfma_f32_16x16x32_bf16(kfr, qf[ks], a, 0, 0, 0); }
                s[kbi][hb] = a;
            }
        float mx = -3.0e38f;
        const LAS float* bt = biasT + (qi + 160 - 32 * kb0 - 8 * fq);
        float bv[5][2][4];
#pragma unroll
        for (int kbi = 0; kbi < 5; ++kbi)
#pragma unroll
            for (int hb = 0; hb < 2; ++hb)
#pragma unroll
                for (int i = 0; i < 4; ++i) bv[kbi][hb][i] = bt[-(32 * kbi + 4 * hb + i)];
#pragma unroll
        for (int kbi = 0; kbi < 5; ++kbi) {
            const float dm = ((n == 0) && (kb0 + kbi < 4)) ? -3.0e38f : 0.f;
#pragma unroll
            for (int hb = 0; hb < 2; ++hb)
#pragma unroll
                for (int i = 0; i < 4; ++i) {
                    const float v = (s[kbi][hb][i] + bv[kbi][hb][i]) + dm;
                    s[kbi][hb][i] = v; mx = fmaxf(mx, v);
                }
        }
        mx = fmaxf(mx, __shfl_xor(mx, 16)); mx = fmaxf(mx, __shfl_xor(mx, 32));
        float sum = 0.f; bf16x8 pf[5];
#pragma unroll
        for (int kbi = 0; kbi < 5; ++kbi) {
            float p[8];
#pragma unroll
            for (int hb = 0; hb < 2; ++hb)
#pragma unroll
                for (int i = 0; i < 4; ++i) { const float e = __expf(s[kbi][hb][i] - mx); p[4 * hb + i] = e; sum += e; }
            u32x4 o; o.x = cvt_pk_bf16(p[0], p[1]); o.y = cvt_pk_bf16(p[2], p[3]); o.z = cvt_pk_bf16(p[4], p[5]); o.w = cvt_pk_bf16(p[6], p[7]);
            pf[kbi] = __builtin_bit_cast(bf16x8, o);
        }
        sum += __shfl_xor(sum, 16); sum += __shfl_xor(sum, 32);
        const float inv = 1.0f / sum;
        bf16_t* op = P_AO + ((size_t)g * M + qrow) * 512 + h * 128 + 4 * fq;
        const unsigned tq = (unsigned)((lane & 15) >> 2), tp = (unsigned)(lane & 3);
#pragma unroll
        for (int c = 0; c < 8; ++c) {
            f32x4 o = (f32x4){0.f, 0.f, 0.f, 0.f};
#pragma unroll
            for (int kbi = 0; kbi < 5; ++kbi) {
                const unsigned r0 = ((unsigned)(32 * (kb0 + kbi) + 8 * fq) + tq) ^ (unsigned)ps;
                const s16x4 lo = tr16(Vimg + off_b(r0, (unsigned)(2 * c) + (tp >> 1)) + 8u * (tp & 1u));
                const s16x4 hi = tr16(Vimg + off_b(r0 + 4u, (unsigned)(2 * c) + (tp >> 1)) + 8u * (tp & 1u));
                o = __builtin_amdgcn_mfma_f32_16x16x32_bf16(cat8(lo, hi), pf[kbi], o, 0, 0, 0);
            }
            u32x2 wv; wv.x = cvt_pk_bf16(o[0] * inv, o[1] * inv); wv.y = cvt_pk_bf16(o[2] * inv, o[3] * inv);
            *(u32x2*)(op + 16 * c) = wv;
        }
        if (fq == 0) P_LSE[((size_t)g * M + qrow) * 4 + h] = mx + __logf(sum);
        WG_SYNC();
    }
}

constexpr int G1_P = 208;
constexpr int G1_QS = 0, G1_KS = 64 * G1_P, G1_KH = 2 * 64 * G1_P;
constexpr int G1_V = 3 * 64 * G1_P;
constexpr int G1_V_P = 400;
constexpr int G1_GL = G1_V + 64 * G1_V_P;
constexpr int G1_TOT = G1_GL + 4096;
constexpr int G1_END = G1_TOT + 1536;
__device__ __forceinline__ bf16x8 tr_frag(const LAS unsigned char* img, int pitch, int row0, int col0, int lane) {
    const int g = lane >> 4, q = (lane & 15) >> 2, p = lane & 3;
    const LAS unsigned char* a = img + (row0 + 8 * g + q) * pitch + (col0 + 4 * p) * 2;
    return cat8(tr16(a), tr16(a + 4 * pitch));
}
__device__ __forceinline__ void gla1_unit(Frame& F, int unit, int l) {
    const int h = unit & 3, c = (unit >> 2) & 63, b = unit >> 8;
    const size_t row0 = (size_t)b * SEQ + 64 * c;
    const bf16_t* Zr = P_Z + row0 * NZ;
    const int tid = opq_tid(), lane = tid & 63, w = __builtin_amdgcn_readfirstlane(tid >> 6);
    LAS unsigned char* QS = F.lds + G1_QS; LAS unsigned char* KS = F.lds + G1_KS; LAS unsigned char* KH = F.lds + G1_KH; LAS unsigned char* VI = F.lds + G1_V;
    LAS float* GLs = (LAS float*)(F.lds + G1_GL); LAS float* TOT = (LAS float*)(F.lds + G1_TOT);
    const int k = tid & 127, tg = tid >> 7;
    const bool act = k < GLA_DK;
    const int kc = act ? k : 0;
    {
        const int t = tid >> 3, j2 = (tid & 7) * 2; const unsigned gw2 = *(const unsigned*)(Zr + (size_t)t * NZ + ZGL + j2);
        u32x4 vv[3], qq[2], kk[2];
#pragma unroll
        for (int i = 0; i < 3; ++i) { const int idx = tid + 512 * i, sr = idx / 24, ch = idx % 24; vv[i] = *(const u32x4*)(Zr + (size_t)sr * NZ + ZBV + h * GLA_DV + ch * 8); }
#pragma unroll
        for (int i = 0; i < 2; ++i) { const int idx = tid + 512 * i; if (idx < 768) { const int sr = idx / 12, ch = idx % 12; const bf16_t* p = Zr + (size_t)sr * NZ + h * GLA_DK + ch * 8; qq[i] = *(const u32x4*)(p + ZBQ); kk[i] = *(const u32x4*)(p + ZBK); } }
        GLs[t * 16 + j2] = bflo(gw2); GLs[t * 16 + j2 + 1] = bfhi(gw2);
#pragma unroll
        for (int i = 0; i < 3; ++i) { const int idx = tid + 512 * i, sr = idx / 24, ch = idx % 24; *(LAS u32x4*)(VI + sr * G1_V_P + ch * 16) = vv[i]; }
#pragma unroll
        for (int i = 0; i < 2; ++i) { const int idx = tid + 512 * i; if (idx < 768) { const int sr = idx / 12, ch = idx % 12; *(LAS u32x4*)(QS + sr * G1_P + ch * 16) = qq[i]; *(LAS u32x4*)(KS + sr * G1_P + ch * 16) = kk[i]; } }
    }
    float wu[16];
#pragma unroll
    for (int j = 0; j < 16; ++j) wu[j] = P_gla_gate_up[((size_t)l * 16 + j) * 384 + h * GLA_DK + kc];
    const float bg = P_gla_gate_b[l * 384 + h * GLA_DK + kc];
    WG_SYNC();
    float bcum[16];
    {
        float run = 0.f;
#pragma unroll
        for (int i = 0; i < 16; ++i) {
            const LAS f32x4* gp = (const LAS f32x4*)(GLs + (16 * tg + i) * 16);
            const f32x4 g0 = gp[0], g1 = gp[1], g2 = gp[2], g3 = gp[3];
            float xg = bg + g0.x * wu[0] + g0.y * wu[1] + g0.z * wu[2] + g0.w * wu[3] + g1.x * wu[4] + g1.y * wu[5] + g1.z * wu[6] + g1.w * wu[7]
                     + g2.x * wu[8] + g2.y * wu[9] + g2.z * wu[10] + g2.w * wu[11] + g3.x * wu[12] + g3.y * wu[13] + g3.z * wu[14] + g3.w * wu[15];
            const float ls = fminf(xg, 0.f) - __logf(1.0f + __expf(-fabsf(xg)));
            run += ls * (1.0f / 16.0f); bcum[i] = run;
        }
        if (act) TOT[tg * GLA_DK + k] = run;
    }
    WG_SYNC();
    {
        float offs = 0.f, blast = 0.f;
#pragma unroll
        for (int q = 0; q < 4; ++q) { const float tv = TOT[q * GLA_DK + kc]; blast += tv; offs += q < tg ? tv : 0.f; }
        if (act) {
            if (tg == 0) P_DL[(size_t)unit * GLA_DK + k] = __expf(blast);
#pragma unroll
            for (int i = 0; i < 16; ++i) {
                const int t = 16 * tg + i; const float bb = bcum[i] + offs;
                LAS bf16_t* qa = (LAS bf16_t*)(QS + t * G1_P + k * 2); LAS bf16_t* ka = (LAS bf16_t*)(KS + t * G1_P + k * 2);
                const float qv = bflo((unsigned)*qa), kv = bflo((unsigned)*ka);
                *qa = (bf16_t)(cvt_pk_bf16(qv * 0.10206207261596575f * __expf(bb), 0.f) & 0xffffu);
                *ka = (bf16_t)(cvt_pk_bf16(kv * __expf(-bb), 0.f) & 0xffffu);
                *(LAS bf16_t*)(KH + t * G1_P + k * 2) = (bf16_t)(cvt_pk_bf16(kv * __expf(blast - bb), 0.f) & 0xffffu);
            }
        }
    }
    WG_SYNC();
    {
        bf16_t* QTp = P_QT; bf16_t* KTp = P_KT;
#pragma unroll
        for (int i = 0; i < 2; ++i) { const int idx = tid + 512 * i; if (idx < 768) { const int sr = idx / 12, ch = idx % 12; const size_t go = (row0 + sr) * 384 + h * GLA_DK + ch * 8;
            *(u32x4*)(QTp + go) = *(const LAS u32x4*)(QS + sr * G1_P + ch * 16); *(u32x4*)(KTp + go) = *(const LAS u32x4*)(KS + sr * G1_P + ch * 16); } }
    }
    bf16_t* SLu = P_SL + (size_t)unit * GLA_DV * GLA_DK;
    const int fr = lane & 15, fq = lane >> 4;
#pragma unroll 3
    for (int j = 0; j < 9; ++j) {
        const int tau = 9 * w + j, vt = tau / 6, kt = tau % 6;
        f32x4 a = (f32x4){0.f, 0.f, 0.f, 0.f};
#pragma unroll
        for (int ks = 0; ks < 2; ++ks) {
            const bf16x8 af = tr_frag(VI, G1_V_P, 32 * ks, 16 * vt, lane);
            const bf16x8 bfv = tr_frag(KH, G1_P, 32 * ks, 16 * kt, lane);
            a = __builtin_amdgcn_mfma_f32_16x16x32_bf16(bfv, af, a, 0, 0, 0);
        }
        { u32x2 wv; wv.x = cvt_pk_bf16(a[0], a[1]); wv.y = cvt_pk_bf16(a[2], a[3]); *(u32x2*)(SLu + (size_t)(16 * vt + fr) * GLA_DK + 16 * kt + 4 * fq) = wv; }
    }
    WG_SYNC();
}
__device__ __forceinline__ void gla_scan(Frame& F) {
    const int ntask = BATCH * 4 * GLA_DV * 12;
    const bf16_t* SLp = P_SL; const float* DLp = P_DL; bf16_t* SPp = P_SP;
    for (int task = F.bid * NT + opq_tid(); task < ntask; task += F.G * NT) {
        const int ko = task % 12, vd = (task / 12) % GLA_DV, bh = task / (12 * GLA_DV), h = bh & 3, b = bh >> 2;
        float st[8];
#pragma unroll
        for (int j = 0; j < 8; ++j) st[j] = 0.f;
#pragma unroll 4
        for (int c = 0; c < NCHK; ++c) {
            const size_t unit = ((size_t)b * NCHK + c) * 4 + h;
            const size_t e = (unit * GLA_DV + vd) * GLA_DK + ko * 8;
            const u32x4 sw = *(const u32x4*)(SLp + e); const f32x4 s0 = (f32x4){bflo(sw.x), bfhi(sw.x), bflo(sw.y), bfhi(sw.y)}, s1 = (f32x4){bflo(sw.z), bfhi(sw.z), bflo(sw.w), bfhi(sw.w)};
            const f32x4 d0 = *(const f32x4*)(DLp + unit * GLA_DK + ko * 8), d1 = *(const f32x4*)(DLp + unit * GLA_DK + ko * 8 + 4);
            u32x4 o; o.x = cvt_pk_bf16(st[0], st[1]); o.y = cvt_pk_bf16(st[2], st[3]); o.z = cvt_pk_bf16(st[4], st[5]); o.w = cvt_pk_bf16(st[6], st[7]);
            *(u32x4*)(SPp + e) = o;
            st[0] = d0.x * st[0] + s0.x; st[1] = d0.y * st[1] + s0.y; st[2] = d0.z * st[2] + s0.z; st[3] = d0.w * st[3] + s0.w;
            st[4] = d1.x * st[4] + s1.x; st[5] = d1.y * st[5] + s1.y; st[6] = d1.z * st[6] + s1.z; st[7] = d1.w * st[7] + s1.w;
        }
    }
}
constexpr int G3_V_P = 400;
__device__ __forceinline__ void gla3_unit(Frame& F, int unit, int l) {
    const int cp = unit & 31, h = (unit >> 5) & 3, b = unit >> 7;
    const int tid = opq_tid(), lane = tid & 63, w = __builtin_amdgcn_readfirstlane(tid >> 6), fr = lane & 15, fq = lane >> 4;
    const int cw = w >> 2, tt = w & 3, c = 2 * cp + cw;
    const size_t row0 = (size_t)b * SEQ + 64 * c;
    LAS unsigned char* VI = F.lds + cw * (64 * G3_V_P);
    u32x4 vreg[6];
    {
        const int lt = tid & 255; const bf16_t* Zr = P_Z + row0 * NZ + ZBV + h * GLA_DV;
#pragma unroll
        for (int i = 0; i < 6; ++i) { const int idx = lt + 256 * i, sr = idx / 24, ch = idx % 24; vreg[i] = *(const u32x4*)(Zr + (size_t)sr * NZ + ch * 8); }
    }
    bf16x8 qf[3];
    { const bf16_t* qp = P_QT + (row0 + 16 * tt + fr) * 384 + h * GLA_DK + 8 * fq;
#pragma unroll
      for (int ks = 0; ks < 3; ++ks) qf[ks] = *(const bf16x8*)(qp + 32 * ks); }
    bf16x8 pf[2];
    const int nblk = (tt >> 1) + 1;
#pragma unroll
    for (int blk = 0; blk < 2; ++blk) {
        u32x4 pw = (u32x4){0u, 0u, 0u, 0u};
        if (blk < nblk) {
            float p[8];
#pragma unroll
            for (int hb = 0; hb < 2; ++hb) {
                const int srow = 32 * blk + 8 * (fr >> 2) + (fr & 3) + 4 * hb;
                const bf16_t* kp = P_KT + (row0 + srow) * 384 + h * GLA_DK + 8 * fq;
                f32x4 a = (f32x4){0.f, 0.f, 0.f, 0.f};
#pragma unroll
                for (int ks = 0; ks < 3; ++ks) a = __builtin_amdgcn_mfma_f32_16x16x32_bf16(*(const bf16x8*)(kp + 32 * ks), qf[ks], a, 0, 0, 0);
#pragma unroll
                for (int i = 0; i < 4; ++i) { const int sidx = 32 * blk + 8 * fq + 4 * hb + i; p[4 * hb + i] = sidx <= 16 * tt + fr ? a[i] : 0.f; }
            }
            pw.x = cvt_pk_bf16(p[0], p[1]); pw.y = cvt_pk_bf16(p[2], p[3]); pw.z = cvt_pk_bf16(p[4], p[5]); pw.w = cvt_pk_bf16(p[6], p[7]);
        }
        pf[blk] = __builtin_bit_cast(bf16x8, pw);
    }
    const size_t gu = ((size_t)b * NCHK + c) * 4 + h;
    const bf16_t* SPu = P_SP + gu * GLA_DV * GLA_DK;
    f32x4 o[12];
#pragma unroll
    for (int vt = 0; vt < 12; ++vt) {
        f32x4 a = (f32x4){0.f, 0.f, 0.f, 0.f};
        const bf16_t* sp = SPu + (size_t)(16 * vt + fr) * GLA_DK + 8 * fq;
#pragma unroll
        for (int ks = 0; ks < 3; ++ks) a = __builtin_amdgcn_mfma_f32_16x16x32_bf16(*(const bf16x8*)(sp + 32 * ks), qf[ks], a, 0, 0, 0);
        o[vt] = a;
    }
    {
        const int lt = tid & 255;
#pragma unroll
        for (int i = 0; i < 6; ++i) { const int idx = lt + 256 * i, sr = idx / 24, ch = idx % 24; *(LAS u32x4*)(VI + sr * G3_V_P + ch * 16) = vreg[i]; }
    }
    WG_SYNC();
    float ss = 0.f;
#pragma unroll
    for (int vt = 0; vt < 12; ++vt) {
        f32x4 a = o[vt];
#pragma unroll
        for (int blk = 0; blk < 2; ++blk) { const bf16x8 vf = tr_frag(VI, G3_V_P, 32 * blk, 16 * vt, lane); a = __builtin_amdgcn_mfma_f32_16x16x32_bf16(vf, pf[blk], a, 0, 0, 0); }
        o[vt] = a; ss += (a[0] * a[0] + a[1] * a[1]) + (a[2] * a[2] + a[3] * a[3]);
    }
    ss += __shfl_xor(ss, 16); ss += __shfl_xor(ss, 32);
    const float rs = 1.0f / sqrtf(ss * (1.f / GLA_DV) + EPS);
    bf16_t* op = P_OMIX + (row0 + 16 * tt + fr) * D + 512 + h * GLA_DV + 4 * fq;
    const float* go = P_gla_out_g + l * GLA_DV + 4 * fq;
#pragma unroll
    for (int vt = 0; vt < 12; ++vt) { const f32x4 gv = *(const f32x4*)(go + 16 * vt);
        u32x2 wv; wv.x = cvt_pk_bf16(o[vt][0] * rs * gv.x, o[vt][1] * rs * gv.y); wv.y = cvt_pk_bf16(o[vt][2] * rs * gv.z, o[vt][3] * rs * gv.w);
        *(u32x2*)(op + 16 * vt) = wv; }
    WG_SYNC();
}

constexpr int SG_V_P = 400;
constexpr int SG_ST = 128 * SG_V_P;
__device__ __forceinline__ void sgu_unit(Frame& F, int unit, int l) {
    const int n = unit & 31, b = unit >> 5;
    const size_t row0 = (size_t)b * SEQ + 128 * n;
    const bf16_t* Zr = P_Z + row0 * NZ;
    const int tid = opq_tid(), lane = tid & 63, w = __builtin_amdgcn_readfirstlane(tid >> 6), fr = lane & 15, fq = lane >> 4;
    LAS unsigned char* VN = F.lds; LAS float* ST = (LAS float*)(F.lds + SG_ST);
    {
        const int t = tid >> 2, qd = tid & 3; const bf16_t* p = Zr + (size_t)t * NZ + ZCV + 192 * qd;
        float s1 = 0.f, s2 = 0.f;
#pragma unroll
        for (int hb = 0; hb < 2; ++hb) {
            u32x4 v[12];
#pragma unroll
            for (int c = 0; c < 12; ++c) v[c] = *(const u32x4*)(p + 96 * hb + 8 * c);
#pragma unroll
            for (int c = 0; c < 12; ++c) {
                const float a0 = gelu_tanh(bflo(v[c].x)), a1 = gelu_tanh(bfhi(v[c].x)), a2 = gelu_tanh(bflo(v[c].y)), a3 = gelu_tanh(bfhi(v[c].y));
                const float a4 = gelu_tanh(bflo(v[c].z)), a5 = gelu_tanh(bfhi(v[c].z)), a6 = gelu_tanh(bflo(v[c].w)), a7 = gelu_tanh(bfhi(v[c].w));
                s1 += ((a0 + a1) + (a2 + a3)) + ((a4 + a5) + (a6 + a7)); s2 += ((a0 * a0 + a1 * a1) + (a2 * a2 + a3 * a3)) + ((a4 * a4 + a5 * a5) + (a6 * a6 + a7 * a7)); }
        }
        s1 += __shfl_xor(s1, 1); s1 += __shfl_xor(s1, 2); s2 += __shfl_xor(s2, 1); s2 += __shfl_xor(s2, 2);
        const float mean = s1 * (1.f / 768.f), var = fmaxf(s2 * (1.f / 768.f) - mean * mean, 0.f);
        if (qd == 0) { ST[2 * t] = mean; ST[2 * t + 1] = 1.0f / sqrtf(var + EPS); }
    }
    WG_SYNC();
#pragma unroll 1
    for (int g = 0; g < 4; ++g) {
        {
            u32x4 v[6];
#pragma unroll
            for (int i = 0; i < 6; ++i) { const int idx = tid + 512 * i, sr = idx / 24, ch = idx % 24; v[i] = *(const u32x4*)(Zr + (size_t)sr * NZ + ZCV + g * 192 + ch * 8); }
#pragma unroll
            for (int i = 0; i < 6; ++i) { const int idx = tid + 512 * i, sr = idx / 24, ch = idx % 24;
                const float mean = ST[2 * sr], rstd = ST[2 * sr + 1];
                const float* lg = P_sgu_ln_g + l * 768 + g * 192 + ch * 8; const float* lb = P_sgu_ln_b + l * 768 + g * 192 + ch * 8;
                const f32x4 g0 = *(const f32x4*)lg, g1 = *(const f32x4*)(lg + 4), b0 = *(const f32x4*)lb, b1 = *(const f32x4*)(lb + 4);
                u32x4 o;
                o.x = cvt_pk_bf16((gelu_tanh(bflo(v[i].x)) - mean) * rstd * g0.x + b0.x, (gelu_tanh(bfhi(v[i].x)) - mean) * rstd * g0.y + b0.y);
                o.y = cvt_pk_bf16((gelu_tanh(bflo(v[i].y)) - mean) * rstd * g0.z + b0.z, (gelu_tanh(bfhi(v[i].y)) - mean) * rstd * g0.w + b0.w);
                o.z = cvt_pk_bf16((gelu_tanh(bflo(v[i].z)) - mean) * rstd * g1.x + b1.x, (gelu_tanh(bfhi(v[i].z)) - mean) * rstd * g1.y + b1.y);
                o.w = cvt_pk_bf16((gelu_tanh(bflo(v[i].w)) - mean) * rstd * g1.z + b1.z, (gelu_tanh(bfhi(v[i].w)) - mean) * rstd * g1.w + b1.w);
                *(LAS u32x4*)(VN + sr * SG_V_P + ch * 16) = o; }
        }
        WG_SYNC();
        const float* Wg = P_sgu_w + ((size_t)l * 4 + g) * 128 * 128;
#pragma unroll 1
        for (int half = 0; half < 2; ++half) {
            const int tt = half == 0 ? w : 7 - w, nks = (tt >> 1) + 1, t = 16 * tt + fr;
            bf16x8 wf[4];
#pragma unroll
            for (int ks = 0; ks < 4; ++ks) {
                u32x4 pw = (u32x4){0u, 0u, 0u, 0u};
                if (ks < nks) { const float* wp = Wg + (size_t)t * 128 + 32 * ks + 8 * fq; const f32x4 a = *(const f32x4*)wp, c4 = *(const f32x4*)(wp + 4); const int s0 = 32 * ks + 8 * fq;
                    pw.x = cvt_pk_bf16(s0 + 0 <= t ? a.x : 0.f, s0 + 1 <= t ? a.y : 0.f); pw.y = cvt_pk_bf16(s0 + 2 <= t ? a.z : 0.f, s0 + 3 <= t ? a.w : 0.f);
                    pw.z = cvt_pk_bf16(s0 + 4 <= t ? c4.x : 0.f, s0 + 5 <= t ? c4.y : 0.f); pw.w = cvt_pk_bf16(s0 + 6 <= t ? c4.z : 0.f, s0 + 7 <= t ? c4.w : 0.f); }
                wf[ks] = __builtin_bit_cast(bf16x8, pw);
            }
            const float bs = P_sgu_b[((size_t)l * 4 + g) * 128 + t];
            const bf16_t* up = Zr + (size_t)t * NZ + ZCU + g * 192 + 4 * fq;
            bf16_t* op = P_OMIX + (row0 + t) * D + 1280 + g * 192 + 4 * fq;
            u32x2 uv[6];
#pragma unroll
            for (int ci = 0; ci < 6; ++ci) uv[ci] = *(const u32x2*)(up + 16 * (6 * half + ci));
#pragma unroll
            for (int ci = 0; ci < 6; ++ci) {
                const int ct = 6 * half + ci;
                f32x4 a = (f32x4){0.f, 0.f, 0.f, 0.f};
#pragma unroll
                for (int ks = 0; ks < 4; ++ks) if (ks < nks) a = __builtin_amdgcn_mfma_f32_16x16x32_bf16(tr_frag(VN, SG_V_P, 32 * ks, 16 * ct, lane), wf[ks], a, 0, 0, 0);
                u32x2 wv; wv.x = cvt_pk_bf16(gelu_tanh(bflo(uv[ci].x)) * (a[0] + bs), gelu_tanh(bfhi(uv[ci].x)) * (a[1] + bs)); wv.y = cvt_pk_bf16(gelu_tanh(bflo(uv[ci].y)) * (a[2] + bs), gelu_tanh(bfhi(uv[ci].y)) * (a[3] + bs));
                *(u32x2*)(op + 16 * ct) = wv;
            }
        }
        WG_SYNC();
    }
}
__device__ __forceinline__ void attn_combine(Frame& F) {
    const size_t ntask = (size_t)M * 64;
    const float* LSEp = P_LSE; const bf16_t* AOp = P_AO; bf16_t* OMp = P_OMIX;
    for (size_t task = (size_t)F.bid * NT + opq_tid(); task < ntask; task += (size_t)F.G * NT) {
        const size_t row = task >> 6; const int ch = (int)(task & 63), h = ch >> 4;
        const float l0 = LSEp[((size_t)0 * M + row) * 4 + h], l1 = LSEp[((size_t)1 * M + row) * 4 + h], l2 = LSEp[((size_t)2 * M + row) * 4 + h];
        const float mx = fmaxf(l0, fmaxf(l1, l2)); const float e0 = __expf(l0 - mx), e1 = __expf(l1 - mx), e2 = __expf(l2 - mx); const float inv = 1.0f / (e0 + e1 + e2);
        const float w0 = e0 * inv, w1 = e1 * inv, w2 = e2 * inv;
        const u32x4 a = *(const u32x4*)(AOp + ((size_t)0 * M + row) * 512 + ch * 8), bq = *(const u32x4*)(AOp + ((size_t)1 * M + row) * 512 + ch * 8), cq = *(const u32x4*)(AOp + ((size_t)2 * M + row) * 512 + ch * 8);
        u32x4 o;
        o.x = cvt_pk_bf16(w0 * bflo(a.x) + w1 * bflo(bq.x) + w2 * bflo(cq.x), w0 * bfhi(a.x) + w1 * bfhi(bq.x) + w2 * bfhi(cq.x));
        o.y = cvt_pk_bf16(w0 * bflo(a.y) + w1 * bflo(bq.y) + w2 * bflo(cq.y), w0 * bfhi(a.y) + w1 * bfhi(bq.y) + w2 * bfhi(cq.y));
        o.z = cvt_pk_bf16(w0 * bflo(a.z) + w1 * bflo(bq.z) + w2 * bflo(cq.z), w0 * bfhi(a.z) + w1 * bfhi(bq.z) + w2 * bfhi(cq.z));
        o.w = cvt_pk_bf16(w0 * bflo(a.w) + w1 * bflo(bq.w) + w2 * bflo(cq.w), w0 * bfhi(a.w) + w1 * bfhi(bq.w) + w2 * bfhi(cq.w));
        *(u32x4*)(OMp + row * D + ch * 8) = o;
    }
}

constexpr int NPH = 10;
__global__ void __launch_bounds__(NT, 2) mega_fwd(Args args) {
    extern __shared__ __attribute__((aligned(16))) unsigned char lds_raw[];
    Frame F;
    F.lds = (LAS unsigned char*)lds_raw;
    F.G = gridDim.x; F.bid = blockIdx.x;
    unsigned char* ws = args.ws;
    volatile LAS unsigned* MISC = (volatile LAS unsigned*)(F.lds + LDS_MISC);
    if (threadIdx.x < 16) MISC[threadIdx.x] = 0u;
    __syncthreads();
    unsigned* ctl = (unsigned*)(ws + WS_CTL);
    const bool single = (args.ph_hi - args.ph_lo) > 1 || (args.l_hi - args.l_lo) > 1;
    XcdBarrier bar; bar.bar = ctl + CW_BAR; bar.x = 0; bar.st = nullptr;
    if (single) bar = xcd_barrier_post(ctl + CW_BAR, MISC);
#ifndef REP_MIX
#define REP_MIX 1
#endif
#ifndef REP_G1
#define REP_G1 1
#endif
#ifndef REP_THIN
#define REP_THIN 1
#endif
#ifndef REP_ATT
#define REP_ATT 1
#endif
#ifndef REP_GLA1
#define REP_GLA1 1
#endif
#ifndef REP_SGU
#define REP_SGU 1
#endif
#ifndef REP_SCAN
#define REP_SCAN 1
#endif
#ifndef REP_G3
#define REP_G3 1
#endif
#ifndef REP_CMB
#define REP_CMB 1
#endif
#ifndef REP_P5
#define REP_P5 1
#endif
#ifndef REP_P8
#define REP_P8 1
#endif
#ifndef PH_MASK
#define PH_MASK 0x3ff
#endif
#define IN(k) (((PH_MASK >> (k)) & 1) && args.ph_lo <= (k) && (k) < args.ph_hi)
#define GRID_BAR() do { if (single) xcd_barrier(bar); } while (0)

    for (int l = args.l_lo; l < args.l_hi; ++l) {
        for (int rp = 0; rp < REP_THIN; ++rp)
        if (IN(0)) { p0_convert(F, l); if (l == 0) cast_rows(F, P_x, P_XN, P_RS1, P_XB8); GRID_BAR(); }
        for (int rp = 0; rp < REP_G1; ++rp)
        if (IN(1)) {
            {
                pg8::Gemm g{P_XB8, P_W8, M, N8, D, D, D}; pg8::StaticOrder S; S.init(M, N8, F.G, F.bid); S.wgm = 8;
                if (F.G == 256) { S.full = 20; S.c0 = 128; S.extra = 2; }
                pg8::EpiStoreBf16 E{P_Z, NZ, P_RS1 + (size_t)l * M, 18, 0, ZGA, W8_INV, true};
                pg8::gemm_phase<pg8::EpiStoreBf16, true, true>(F.lds, g, S, E);
            }
            {
                pg8::Gemm g{P_XN, P_WIN, M, NB, D, D, D}; pg8::StaticOrder S; S.init(M, NB, F.G, F.bid); S.wgm = 8;
                pg8::EpiStoreBf16 E{P_Z, NZ, P_RS1 + (size_t)l * M, 12, ZBQ, ZGL, 1.0f, false};
                pg8::gemm_phase<pg8::EpiStoreBf16, true, false>(F.lds, g, S, E);
            }
            GRID_BAR();
        }
        for (int rp = 0; rp < REP_MIX; ++rp) {
        if (IN(2)) {
            for (int q = 0; q < REP_ATT; ++q) for (int u = F.bid; u < 768; u += F.G) attn_seg(F, u, l);
            for (int q = 0; q < REP_GLA1; ++q) for (int u = F.bid; u < 2048; u += F.G) gla1_unit(F, u, l);
            for (int q = 0; q < REP_SGU; ++q) for (int u = F.bid; u < 256; u += F.G) sgu_unit(F, u, l);
            GRID_BAR();
        }
        if (IN(3)) { for (int q = 0; q < REP_SCAN; ++q) gla_scan(F); GRID_BAR(); }
        if (IN(4)) {
            for (int q = 0; q < REP_G3; ++q) for (int u = F.bid; u < 1024; u += F.G) gla3_unit(F, u, l);
            for (int q = 0; q < REP_CMB; ++q) attn_combine(F);
            GRID_BAR();
        }
        }
        for (int rp = 0; rp < REP_P5; ++rp)
        if (IN(5)) {
            {
                pg8::Gemm g{P_OMIX, P_WBR, M, D, D, D, D}; pg8::StaticOrder S; S.init(M, D, F.G, F.bid); S.nbr = 3;
                pg8::EpiGate E{P_Y, P_Z + ZGA, D, NZ};
                pg8::gemm_phase<pg8::EpiGate, true, false, true>(F.lds, g, S, E);
            }
            GRID_BAR();
        }
        if (IN(6)) {
            pg8::Gemm g{P_Y, P_WO, M, D, D, D, D}; pg8::StaticOrder S; S.init(M, D, F.G, F.bid);
            pg8::EpiRes E{P_XN, (float*)nullptr, D, P_RS2 + (size_t)l * M, (unsigned char*)nullptr};
            pg8::gemm_phase<pg8::EpiRes, true>(F.lds, g, S, E);
            GRID_BAR();
        }
        for (int rp = 0; rp < REP_THIN; ++rp)
        if (IN(7)) { }
        for (int rp = 0; rp < REP_P8; ++rp)
        if (IN(8)) {
            pg8::Gemm g{P_XN, P_WFI, M, NFI, D, D, D}; pg8::StaticOrder S; S.init(M, NFI, F.G, F.bid); S.wgm = 8;
            pg8::EpiSwiGLU E{P_H, DFF, P_RS2 + (size_t)l * M};
            pg8::gemm_phase<pg8::EpiSwiGLU, true>(F.lds, g, S, E);
            GRID_BAR();
        }
        if (IN(9)) {
            pg8::Gemm g{P_H, P_WFO, M, D, DFF, DFF, DFF}; pg8::StaticOrder S; S.init(M, D, F.G, F.bid);
            pg8::EpiRes E{P_XN, (l + 1 < DEPTH) ? (float*)nullptr : P_out, D, P_RS1 + (size_t)(l + 1 < DEPTH ? l + 1 : 0) * M, (l + 1 < DEPTH) ? P_XB8 : (unsigned char*)nullptr};
            pg8::gemm_phase<pg8::EpiRes, true>(F.lds, g, S, E);
            GRID_BAR();
        }
    }
#undef IN
#undef GRID_BAR
}

extern "C" void kernel_launch(void* const* d_in, const int* in_sizes, int n_in, void* d_out, int out_size, void* d_ws, size_t ws_size, hipStream_t stream) {
    static int grid = 0;
    if (grid == 0) {
        if (n_in != 18 || out_size != M * D || ws_size < WS_END) { fprintf(stderr, "kernel_launch: unexpected shapes (n_in %d, out %d, ws %zu < %zu)\n", n_in, out_size, ws_size, (size_t)WS_END); grid = -1; return; }
        int dev = 0, cus = 0, per_cu = 0;
        if (hipGetDevice(&dev) != hipSuccess || hipDeviceGetAttribute(&cus, hipDeviceAttributeMultiprocessorCount, dev) != hipSuccess) { grid = -1; return; }
        if (hipFuncSetAttribute((const void*)mega_fwd, hipFuncAttributeMaxDynamicSharedMemorySize, LDS_BYTES) != hipSuccess) { fprintf(stderr, "kernel_launch: hipFuncSetAttribute failed\n"); grid = -1; return; }
        if (hipOccupancyMaxActiveBlocksPerMultiprocessor(&per_cu, (const void*)mega_fwd, NT, LDS_BYTES) != hipSuccess || per_cu < 1) { fprintf(stderr, "kernel_launch: occupancy query says %d\n", per_cu); }
        (void)hipGetLastError();
        grid = cus;
    }
    if (grid < 0) return;
    (void)hipMemsetAsync((char*)d_ws + WS_CTL, 0, CTL_ZERO_BYTES, stream);
    Args a{};
    for (int i = 0; i < 18; ++i) a.in[i] = (const float*)d_in[i];
    a.out = (float*)d_out; a.ws = (unsigned char*)d_ws;
#if MK_MULTI
    for (int l = 0; l < DEPTH; ++l)
        for (int p = 0; p < NPH; ++p) { a.l_lo = l; a.l_hi = l + 1; a.ph_lo = p; a.ph_hi = p + 1; hipLaunchKernelGGL(mega_fwd, dim3(grid), dim3(NT), LDS_BYTES, stream, a); }
#else
    a.l_lo = 0; a.l_hi = DEPTH; a.ph_lo = 0; a.ph_hi = NPH;
    hipLaunchKernelGGL(mega_fwd, dim3(grid), dim3(NT), LDS_BYTES, stream, a);
#endif
}
```

```cpp
#include <hip/hip_runtime.h>
#include <cstdio>
#include <cstdint>

#ifndef MK_MULTI
#define MK_MULTI 0
#endif

#define LAS __attribute__((address_space(3)))
#define GAS __attribute__((address_space(1)))
typedef unsigned short bf16_t;
typedef short bf16x8 __attribute__((ext_vector_type(8)));
typedef short s16x4 __attribute__((ext_vector_type(4)));
typedef float f32x4 __attribute__((ext_vector_type(4)));
typedef float f32x2 __attribute__((ext_vector_type(2)));
typedef unsigned u32x4 __attribute__((ext_vector_type(4)));
typedef unsigned u32x2 __attribute__((ext_vector_type(2)));

constexpr int D = 2048, BATCH = 8, SEQ = 4096, DEPTH = 4, M = BATCH * SEQ;
constexpr int NZ = 14080;
constexpr int ZQ = 0, ZK = 1536, ZV = 3072, ZBQ = 4608, ZBK = 4992, ZBV = 5376, ZCU = 6144, ZCV = 6912, ZGA = 7680, ZGB = 9728, ZGC = 11776, ZGL = 13824;
constexpr int DIN = 13840, DFF = 5632, NFI = 2 * DFF;
constexpr int GLA_DK = 96, GLA_DV = 192, NCHK = SEQ / 64;
constexpr float EPS = 1e-6f;
constexpr int NT = 512, NWAVES = 8;

constexpr size_t al256(size_t x) { return (x + 255) & ~(size_t)255; }
constexpr size_t WS_CTL = 0, CTL_ZERO_BYTES = 4u << 20;
typedef unsigned long long rs_t;
constexpr float RS_SCALE = 16777216.0f, RS_INV = 1.0f / 16777216.0f;
constexpr size_t WS_RS1 = 256u << 10;
constexpr size_t WS_RS2 = WS_RS1 + (size_t)DEPTH * M * 8;
static_assert(WS_RS2 + (size_t)DEPTH * M * 8 <= CTL_ZERO_BYTES, "RS buffers inside the zeroed region");
constexpr int N8 = 10752, NB = 3328;
constexpr float W8_SCALE = 256.0f, W8_INV = 1.0f / 256.0f;
constexpr size_t WS_WIN = CTL_ZERO_BYTES;
constexpr size_t WS_W8 = WS_WIN + (size_t)NB * D * 2;
constexpr size_t WS_XB8 = WS_W8 + (size_t)N8 * D;
constexpr size_t WS_WBR = WS_XB8 + (size_t)M * D;
constexpr size_t WS_WO = WS_WBR + (size_t)D * D * 2;
constexpr size_t WS_WFI = WS_WO + (size_t)D * D * 2;
constexpr size_t WS_WFO = WS_WFI + (size_t)NFI * D * 2;
constexpr size_t WS_XN = WS_WFO + (size_t)D * DFF * 2;
constexpr size_t WS_Y = WS_XN + (size_t)M * D * 2;
constexpr size_t WS_OMIX = WS_Y + (size_t)M * D * 2;
constexpr size_t WS_Z = WS_OMIX + (size_t)M * D * 2;
constexpr size_t WS_SP = WS_Z + (size_t)M * NZ * 2;
constexpr size_t WS_QT = WS_SP + (size_t)BATCH * NCHK * 4 * GLA_DV * GLA_DK * 2;
constexpr size_t WS_KT = WS_QT + (size_t)M * 384 * 2;
constexpr size_t WS_DL = WS_KT + (size_t)M * 384 * 2;
constexpr size_t WS_LSE = WS_DL + (size_t)BATCH * NCHK * 4 * GLA_DK * 4;
constexpr size_t WS_END = WS_LSE + (size_t)3 * M * 4 * 4;
constexpr size_t OUT_SL = 0;
constexpr size_t OUT_AO = OUT_SL + (size_t)BATCH * NCHK * 4 * GLA_DV * GLA_DK * 2;
static_assert(OUT_AO + (size_t)3 * M * 512 * 2 <= (size_t)M * D * 4, "scratch fits in d_out");
constexpr int CW_BAR = 4096;

typedef __bf16 bf16x2_t __attribute__((ext_vector_type(2)));
__device__ __forceinline__ unsigned cvt_pk_bf16(float lo, float hi) { const f32x2 v = {lo, hi}; return __builtin_bit_cast(unsigned, __builtin_convertvector(v, bf16x2_t)); }
__device__ __forceinline__ float bflo(unsigned w) { return __uint_as_float(w << 16); }
__device__ __forceinline__ float bfhi(unsigned w) { return __uint_as_float(w & 0xffff0000u); }
__device__ __forceinline__ float fast_rcp(float x) { return __builtin_amdgcn_rcpf(x); }
__device__ __forceinline__ float sigmoidf_(float x) { return fast_rcp(1.0f + __expf(-x)); }
__device__ __forceinline__ float gelu_tanh(float x) { const float u = 0.7978845608028654f * (x + 0.044715f * x * x * x); return x * fast_rcp(1.0f + __expf(-2.0f * u)); }
__device__ __forceinline__ float wave_sum(float v) {
#pragma unroll
    for (int o = 1; o < 64; o <<= 1) v += __shfl_xor(v, o);
    return v;
}
__device__ __forceinline__ int opq_tid() { int t = threadIdx.x; asm volatile("" : "+v"(t)); return t; }
#define LDS_WAIT() asm volatile("s_waitcnt lgkmcnt(0)" ::: "memory")
#define WG_SYNC() asm volatile("s_waitcnt lgkmcnt(0)\n\ts_barrier" ::: "memory")
#define VM_WAIT() asm volatile("s_waitcnt vmcnt(0)" ::: "memory")

namespace pg8 {
constexpr int BM = 256, BK = 64, HALF = 128, HTB = HALF * BK * 2, STAGE_BYTES = 8 * HTB, NXCD = 8;
typedef int v4i_t __attribute__((ext_vector_type(4)));
typedef int v8i_t __attribute__((ext_vector_type(8)));
__host__ __device__ __forceinline__ int lds_byte(int r, int c) { const int st = (r >> 4) * 2 + (c >> 5), rr = r & 15, cc = c & 31, ob = rr * 64 + cc * 2; return st * 1024 + (ob ^ (((ob >> 9) & 1) << 5)); }
__host__ __device__ __forceinline__ void stage_rc(int b, int& R, int& C) { const int st = b / 1024, sb = b % 1024, swz = sb ^ (((sb >> 9) & 1) << 5); R = (st >> 1) * 16 + swz / 64; C = (st & 1) * 32 + (swz % 64) / 2; }
__host__ __device__ __forceinline__ void stage_rc8(int b, int& R, int& Cb) { const int rb = b >> 11, within = b & 2047, slot = within >> 5, half = (within >> 4) & 1, fq = slot >> 4, fr = slot & 15, k = half ^ (fq & 1); R = 16 * rb + fr; Cb = 64 * k + 16 * fq; }
__host__ __device__ __forceinline__ int perm32(int rho) { const int n = rho >> 4, i = rho & 15; return 8 * (i >> 2) + 4 * n + (i & 3); }
struct Unit { int pm, pn, br; };
struct Gemm { const void* A; const void* Bt; int M, N, K, lda, ldb; };
struct StaticOrder {
    int nM, nN, nwg, G, c, full, c0, extra, nbr, wgm;
    __host__ __device__ void init(int M_, int N_, int G_, int c_) { nM = M_ / BM; nN = N_ / BM; nwg = nM * nN; G = G_; c = c_; full = 0x3fffffff; c0 = 0; extra = 0; nbr = 1; wgm = 4; }
    __host__ __device__ bool next(int i, Unit& u) const {
        long L; u.br = 0;
        if (nbr > 1) { u.br = i % nbr; i /= nbr; }
        if (i < full) L = (long)i * G + c; else { const int j = i - full; if (c < c0 || j >= extra) return false; L = (long)full * G + (long)(c - c0) * extra + j; }
        if (L >= nwg) return false;
        int wgid = (int)L; const int xcd = wgid % NXCD; { const int q = nwg / NXCD, r = nwg % NXCD, off = wgid / NXCD; wgid = (xcd < r ? xcd * (q + 1) : r * (q + 1) + (xcd - r) * q) + off; }
        const int nig = wgm * nN, gid = wgid / nig, fm = gid * wgm, gsz = (nM - fm) < wgm ? (nM - fm) : wgm;
        u.pm = fm + ((wgid % nig) % gsz); u.pn = ((wgid % nig) / gsz + ((nwg % (NXCD * nig)) == 0 ? xcd * (nN / NXCD) : 0)) % nN; return true;
    }
};
struct EpiStoreBf16 {
    static constexpr bool PERM = true, ROWSCALE = true, SWAP = true;
    bf16_t* O; int ldc; const rs_t* rs; int split, off_lo, off_hi; float mul;
    __device__ __forceinline__ void operator()(const f32x4 (&acc)[2][2][4][2], const Unit& u, int wr, int wc, int fr, int fq, const LAS float* rsl) const {
        const int row0 = u.pm * BM + wr * 64 + 4 * fq, col0 = (u.pn < split ? off_lo + u.pn * BM : off_hi + (u.pn - split) * BM) + wc * 64 + 4 * fr;
#pragma unroll
        for (int ai = 0; ai < 2; ++ai)
#pragma unroll
            for (int m = 0; m < 4; ++m) { bf16_t* rowp = O + (size_t)(row0 + ai * HALF + m * 16) * ldc + col0;
                const f32x4 sc = *(const LAS f32x4*)(rsl + wr * 64 + 4 * fq + ai * HALF + m * 16) * mul;
#pragma unroll
                for (int i = 0; i < 4; ++i) { u32x2 w; w.x = cvt_pk_bf16(acc[ai][0][m][0][i] * sc[i], acc[ai][0][m][1][i] * sc[i]); w.y = cvt_pk_bf16(acc[ai][1][m][0][i] * sc[i], acc[ai][1][m][1][i] * sc[i]);
                    __builtin_nontemporal_store(w, (u32x2*)(rowp + (size_t)i * ldc)); } }
    }
};
struct EpiGate {
    static constexpr bool PERM = true, ROWSCALE = false, SWAP = false;
    bf16_t* Y; const bf16_t* G; int ldy, ldg;
    static __device__ __forceinline__ float e_neg(float g) { return __expf(-__builtin_amdgcn_fmed3f(g, -30.0f, 30.0f)); }
    __device__ __forceinline__ void operator()(f32x4 (&acc)[2][2][4][2], const Unit& u, int wr, int wc, int fr, int fq, const LAS float*) const {
        const int row0 = u.pm * BM + wr * 64 + fr, col0 = u.pn * BM + wc * 32 + 8 * fq; const bf16_t* Gb = G + u.br * D;
        if (u.br < 2) {
#pragma unroll
            for (int ai = 0; ai < 2; ++ai) {
                u32x4 g0[4][2], g1[4][2];
#pragma unroll
                for (int m = 0; m < 4; ++m) { const size_t row = (size_t)(row0 + ai * HALF + m * 16);
#pragma unroll
                    for (int bj = 0; bj < 2; ++bj) { g0[m][bj] = *(const u32x4*)(Gb + row * ldg + col0 + bj * HALF); g1[m][bj] = *(const u32x4*)(Gb + D + row * ldg + col0 + bj * HALF); } }
#pragma unroll
                for (int m = 0; m < 4; ++m)
#pragma unroll
                    for (int bj = 0; bj < 2; ++bj) { const u32x4 a = g0[m][bj], b = g1[m][bj];
                        const unsigned aw[4] = {a.x, a.y, a.z, a.w}, bw[4] = {b.x, b.y, b.z, b.w};
#pragma unroll
                        for (int q = 0; q < 4; ++q) {
                            const float rl = (1.0f + e_neg(bflo(bw[q]))) * fast_rcp(1.0f + e_neg(bflo(aw[q]))), rh = (1.0f + e_neg(bfhi(bw[q]))) * fast_rcp(1.0f + e_neg(bfhi(aw[q])));
                            acc[ai][bj][m][q >> 1][2 * (q & 1)] *= rl; acc[ai][bj][m][q >> 1][2 * (q & 1) + 1] *= rh; } }
                asm volatile("" ::: "memory"); }
        } else {
#pragma unroll
            for (int ai = 0; ai < 2; ++ai) {
                u32x4 g[4][2];
#pragma unroll
                for (int m = 0; m < 4; ++m) { const size_t row = (size_t)(row0 + ai * HALF + m * 16);
#pragma unroll
                    for (int bj = 0; bj < 2; ++bj) g[m][bj] = *(const u32x4*)(Gb + row * ldg + col0 + bj * HALF); }
#pragma unroll
                for (int m = 0; m < 4; ++m) { const size_t row = (size_t)(row0 + ai * HALF + m * 16);
#pragma unroll
                    for (int bj = 0; bj < 2; ++bj) { const f32x4 v0 = acc[ai][bj][m][0], v1 = acc[ai][bj][m][1]; const u32x4 gg = g[m][bj];
                        float o[8];
                        o[0] = v0[0] * fast_rcp(1.0f + e_neg(bflo(gg.x))); o[1] = v0[1] * fast_rcp(1.0f + e_neg(bfhi(gg.x)));
                        o[2] = v0[2] * fast_rcp(1.0f + e_neg(bflo(gg.y))); o[3] = v0[3] * fast_rcp(1.0f + e_neg(bfhi(gg.y)));
                        o[4] = v1[0] * fast_rcp(1.0f + e_neg(bflo(gg.z))); o[5] = v1[1] * fast_rcp(1.0f + e_neg(bfhi(gg.z)));
                        o[6] = v1[2] * fast_rcp(1.0f + e_neg(bflo(gg.w))); o[7] = v1[3] * fast_rcp(1.0f + e_neg(bfhi(gg.w)));
                        u32x4 w; w.x = cvt_pk_bf16(o[0], o[1]); w.y = cvt_pk_bf16(o[2], o[3]); w.z = cvt_pk_bf16(o[4], o[5]); w.w = cvt_pk_bf16(o[6], o[7]);
                        *(u32x4*)(Y + row * ldy + col0 + bj * HALF) = w; } }
                asm volatile("" ::: "memory"); }
        }
    }
};
struct EpiRes {
    static constexpr bool PERM = true, ROWSCALE = false, SWAP = false;
    bf16_t* xb; float* outf; int ldc; rs_t* rs; unsigned char* xb8;
    __device__ __forceinline__ void operator()(const f32x4 (&acc)[2][2][4][2], const Unit& u, int wr, int wc, int fr, int fq, const LAS float*) const {
        const int row0 = u.pm * BM + wr * 64 + fr, col0 = u.pn * BM + wc * 32 + 8 * fq;
#pragma unroll
        for (int ai = 0; ai < 2; ++ai) {
            u32x4 bs[4][2];
#pragma unroll
            for (int m = 0; m < 4; ++m) { const size_t off = (size_t)(row0 + ai * HALF + m * 16) * ldc + col0;
#pragma unroll
                for (int bj = 0; bj < 2; ++bj) bs[m][bj] = *(const u32x4*)(xb + off + bj * HALF); }
#pragma unroll
            for (int m = 0; m < 4; ++m) { const size_t off = (size_t)(row0 + ai * HALF + m * 16) * ldc + col0; float ss = 0.f;
#pragma unroll
                for (int bj = 0; bj < 2; ++bj) { const u32x4 b4 = bs[m][bj];
                    const f32x4 o0 = (f32x4){bflo(b4.x), bfhi(b4.x), bflo(b4.y), bfhi(b4.y)} + acc[ai][bj][m][0], o1 = (f32x4){bflo(b4.z), bfhi(b4.z), bflo(b4.w), bfhi(b4.w)} + acc[ai][bj][m][1];
                    if (outf) { *(f32x4*)(outf + off + bj * HALF) = o0; *(f32x4*)(outf + off + bj * HALF + 4) = o1; }
                    else { u32x4 w; w.x = cvt_pk_bf16(o0[0], o0[1]); w.y = cvt_pk_bf16(o0[2], o0[3]); w.z = cvt_pk_bf16(o1[0], o1[1]); w.w = cvt_pk_bf16(o1[2], o1[3]); *(u32x4*)(xb + off + bj * HALF) = w;
                        ss += ((o0[0] * o0[0] + o0[1] * o0[1]) + (o0[2] * o0[2] + o0[3] * o0[3])) + ((o1[0] * o1[0] + o1[1] * o1[1]) + (o1[2] * o1[2] + o1[3] * o1[3])); }
                    if (xb8) { u32x2 q; q.x = 0u; q.y = 0u; q.x = __builtin_amdgcn_cvt_pk_fp8_f32(o0[0], o0[1], q.x, false); q.x = __builtin_amdgcn_cvt_pk_fp8_f32(o0[2], o0[3], q.x, true);
                        q.y = __builtin_amdgcn_cvt_pk_fp8_f32(o1[0], o1[1], q.y, false); q.y = __builtin_amdgcn_cvt_pk_fp8_f32(o1[2], o1[3], q.y, true); *(u32x2*)(xb8 + off + bj * HALF) = q; } }
                if (!outf) { ss += __shfl_xor(ss, 16); ss += __shfl_xor(ss, 32); if (fq == 0) __hip_atomic_fetch_add(rs + row0 + ai * HALF + m * 16, (rs_t)(ss * RS_SCALE + 0.5f), __ATOMIC_RELAXED, __HIP_MEMORY_SCOPE_AGENT); } }
            asm volatile("" ::: "memory"); }
    }
};
struct EpiSwiGLU {
    static constexpr bool PERM = true, ROWSCALE = true, SWAP = false;
    bf16_t* H; int ldh; const rs_t* rs;
    __device__ __forceinline__ void operator()(const f32x4 (&acc)[2][2][4][2], const Unit& u, int wr, int wc, int fr, int fq, const LAS float* rsl) const {
        const int row0 = u.pm * BM + wr * 64 + fr, col0 = u.pn * HALF + wc * 32 + 8 * fq;
#pragma unroll
        for (int ai = 0; ai < 2; ++ai)
#pragma unroll
            for (int m = 0; m < 4; ++m) { const float sc = rsl[wr * 64 + fr + ai * HALF + m * 16];
                const f32x4 g0 = acc[ai][0][m][0] * sc, g1 = acc[ai][0][m][1] * sc, u0 = acc[ai][1][m][0] * sc, u1 = acc[ai][1][m][1] * sc;
                float o[8];
#pragma unroll
                for (int j = 0; j < 4; ++j) { o[j] = g0[j] * sigmoidf_(g0[j]) * u0[j]; o[4 + j] = g1[j] * sigmoidf_(g1[j]) * u1[j]; }
                u32x4 w; w.x = cvt_pk_bf16(o[0], o[1]); w.y = cvt_pk_bf16(o[2], o[3]); w.z = cvt_pk_bf16(o[4], o[5]); w.w = cvt_pk_bf16(o[6], o[7]);
                __builtin_nontemporal_store(w, (u32x4*)(H + (size_t)(row0 + ai * HALF + m * 16) * ldh + col0)); }
    }
};

template <class Epi, bool ALIGN_EPI, bool FP8 = false, bool BR3 = false>
__device__ __forceinline__ void gemm_phase(LAS unsigned char* lds, const Gemm g, const StaticOrder& S, const Epi& E) {
    const int tid = opq_tid(), wid = __builtin_amdgcn_readfirstlane(tid >> 6), lane = tid & 63, wr = wid >> 2, wc = wid & 3, fr = lane & 15, fq = lane >> 4;
    constexpr int ESZ = FP8 ? 1 : 2;
    const int K = g.K; int nt = K * ESZ / (BK * 2);
#define PG8_KOFF(u) (BR3 ? ((u).br == 0 ? 0 : ((u).br == 1 ? 1024 : 2560)) : 0)
#define PG8_NT(u) (BR3 ? ((u).br == 0 ? 8 : 12) : nt)
    unsigned voffA[2], voffB[2];
#pragma unroll
    for (int i = 0; i < 2; ++i) { int R, C; if constexpr (FP8) stage_rc8(tid * 16 + i * 8192, R, C); else { stage_rc(tid * 16 + i * 8192, R, C); C *= 2; }
        const int Rb = Epi::SWAP ? (64 * (R >> 5) + 4 * (R & 15) + ((R >> 4) & 1)) : (Epi::PERM ? ((R & ~31) + perm32(R & 31)) : R);
        voffA[i] = (unsigned)(R * g.lda * ESZ + C); voffB[i] = (unsigned)(Rb * g.ldb * ESZ + C); }
    const size_t kstep = (size_t)(BK * 2);
    const size_t hstepA = (size_t)HALF * g.lda * ESZ, hstepB = (size_t)(Epi::SWAP ? 2 : HALF) * g.ldb * ESZ;
    const size_t tstepA = 2 * hstepA, tstepB = (size_t)BM * g.ldb * ESZ;
    const unsigned ldsw = (unsigned)wid * 1024u;
    const int aoff = FP8 ? wr * 8192 + lane * 32 : lds_byte(wr * 64 + fr, fq * 8), boff = FP8 ? wc * 4096 + lane * 32 : lds_byte(wc * 32 + fr, fq * 8);
    LAS float* rsl = (LAS float*)(lds + STAGE_BYTES);
#define PG8_SA(b, h) (((b) * 2 + (h)) * HTB)
#define PG8_SB(b, h) ((4 + (b) * 2 + (h)) * HTB)
#define PG8_STAGE(bufoff, gbase, voff) do { _Pragma("unroll") for (int _i = 0; _i < 2; ++_i) \
        __builtin_amdgcn_global_load_lds((const unsigned*)((const char*)(gbase) + (voff)[_i]), (LAS unsigned*)(lds + (bufoff) + ldsw + _i * 8192), 16, 0, 0); } while (0)
#define PG8_LDA(dst, b, h) do { _Pragma("unroll") for (int m = 0; m < 4; ++m) { if constexpr (FP8) { const v4i_t lo_ = *(const LAS v4i_t*)(lds + PG8_SA(b, h) + aoff + m * 2048), hi_ = *(const LAS v4i_t*)(lds + PG8_SA(b, h) + aoff + m * 2048 + 16); dst##8[m] = __builtin_shufflevector(lo_, hi_, 0, 1, 2, 3, 4, 5, 6, 7); } \
        else { _Pragma("unroll") for (int k = 0; k < 2; ++k) dst[m][k] = *(const LAS bf16x8*)(lds + PG8_SA(b, h) + aoff + m * 2048 + k * 1024); } } } while (0)
#define PG8_LDB(dst, b, h) do { _Pragma("unroll") for (int n = 0; n < 2; ++n) { if constexpr (FP8) { const v4i_t lo_ = *(const LAS v4i_t*)(lds + PG8_SB(b, h) + boff + n * 2048), hi_ = *(const LAS v4i_t*)(lds + PG8_SB(b, h) + boff + n * 2048 + 16); dst##8[n] = __builtin_shufflevector(lo_, hi_, 0, 1, 2, 3, 4, 5, 6, 7); } \
        else { _Pragma("unroll") for (int k = 0; k < 2; ++k) dst[n][k] = *(const LAS bf16x8*)(lds + PG8_SB(b, h) + boff + n * 2048 + k * 1024); } } } while (0)
#define PG8_MMA(ai, bj, At, Bt) do { __builtin_amdgcn_s_setprio(1); _Pragma("unroll") for (int m = 0; m < 4; ++m) _Pragma("unroll") for (int n = 0; n < 2; ++n) { \
        if constexpr (FP8) { if constexpr (Epi::SWAP) asm volatile("v_mfma_f32_16x16x128_f8f6f4 %0, %1, %2, %0" : "+v"(acc[ai][bj][m][n]) : "v"(At##8[m]), "v"(Bt##8[n])); \
            else asm volatile("v_mfma_f32_16x16x128_f8f6f4 %0, %1, %2, %0" : "+v"(acc[ai][bj][m][n]) : "v"(Bt##8[n]), "v"(At##8[m])); }   \
        else { _Pragma("unroll") for (int k = 0; k < 2; ++k) acc[ai][bj][m][n] = Epi::SWAP ? __builtin_amdgcn_mfma_f32_16x16x32_bf16(At[m][k], Bt[n][k], acc[ai][bj][m][n], 0, 0, 0) : __builtin_amdgcn_mfma_f32_16x16x32_bf16(Bt[n][k], At[m][k], acc[ai][bj][m][n], 0, 0, 0); } } __builtin_amdgcn_s_setprio(0); } while (0)
#define PG8_WAIT_V(n) asm volatile("s_waitcnt vmcnt(" #n ")" ::: "memory")
#define PG8_WAIT_L(n) asm volatile("s_waitcnt lgkmcnt(" #n ")" ::: "memory")
#define PG8_BAR __builtin_amdgcn_s_barrier()
#define PG8_SCHED __builtin_amdgcn_sched_barrier(0)
    Unit cur, nxt; int ui = 0;
    if (!S.next(0, cur)) return;
    f32x4 acc[2][2][4][2];
#pragma unroll
    for (int a = 0; a < 2; ++a)
#pragma unroll
        for (int b = 0; b < 2; ++b)
#pragma unroll
            for (int m = 0; m < 4; ++m)
#pragma unroll
                for (int n = 0; n < 2; ++n) acc[a][b][m][n] = (f32x4){0.f, 0.f, 0.f, 0.f};
    bf16x8 At[4][2], B0[2][2], B1[2][2];
    v8i_t At8[4], B08[2], B18[2];
    const char* cA = (const char*)g.A + (size_t)cur.pm * tstepA + PG8_KOFF(cur); const char* cB = (const char*)g.Bt + (size_t)cur.pn * tstepB + PG8_KOFF(cur);
    PG8_STAGE(PG8_SB(0, 0), cB, voffB); PG8_STAGE(PG8_SB(0, 1), cB + hstepB, voffB); PG8_STAGE(PG8_SA(0, 0), cA, voffA); PG8_STAGE(PG8_SA(0, 1), cA + hstepA, voffA);
    if (wr == 1) PG8_BAR;
    PG8_WAIT_V(2); PG8_BAR;
    PG8_STAGE(PG8_SB(1, 0), cB + kstep, voffB); PG8_STAGE(PG8_SA(1, 0), cA + kstep, voffA); PG8_STAGE(PG8_SB(1, 1), cB + hstepB + kstep, voffB);
    PG8_WAIT_V(6); PG8_BAR;
    for (;;) {
        const bool has_next = S.next(ui + 1, nxt);
        rs_t rv = 0; if constexpr (Epi::ROWSCALE) { const rs_t* rp = E.rs + cur.pm * BM + (tid & 255); asm volatile("global_load_dwordx2 %0, %1, off" : "=v"(rv) : "v"(rp) : "memory"); }
        const char* nA = has_next ? (const char*)g.A + (size_t)nxt.pm * tstepA + PG8_KOFF(nxt) : cA; const char* nB = has_next ? (const char*)g.Bt + (size_t)nxt.pn * tstepB + PG8_KOFF(nxt) : cB;
        nt = PG8_NT(cur);
        for (int t = 0; t < nt; t += 2) {
            const bool last = (t == nt - 2);
            const char* a1 = cA + (size_t)(t + 1) * kstep;
            const char* a2 = last ? nA : cA + (size_t)(t + 2) * kstep; const char* b2 = last ? nB : cB + (size_t)(t + 2) * kstep;
            const char* a3 = a2 + kstep; const char* b3 = b2 + kstep;
            PG8_LDB(B0, 0, 0); PG8_LDB(B1, 0, 1); PG8_SCHED; PG8_LDA(At, 0, 0); PG8_STAGE(PG8_SA(1, 1), a1 + hstepA, voffA);
            PG8_WAIT_V(8); PG8_WAIT_L(0); PG8_BAR; PG8_MMA(0, 0, At, B0); PG8_MMA(0, 1, At, B1); PG8_BAR; PG8_SCHED;
            PG8_LDA(At, 0, 1); PG8_STAGE(PG8_SB(0, 0), b2, voffB); PG8_STAGE(PG8_SB(0, 1), b2 + hstepB, voffB); PG8_STAGE(PG8_SA(0, 0), a2, voffA);
            PG8_WAIT_V(8); PG8_WAIT_L(0); PG8_BAR; PG8_MMA(1, 0, At, B0); PG8_MMA(1, 1, At, B1); PG8_BAR; PG8_SCHED;
            PG8_LDB(B0, 1, 0); PG8_LDB(B1, 1, 1); PG8_SCHED; PG8_LDA(At, 1, 0); PG8_STAGE(PG8_SA(0, 1), a2 + hstepA, voffA);
            PG8_WAIT_V(8); PG8_WAIT_L(0); PG8_BAR; PG8_MMA(0, 0, At, B0); PG8_MMA(0, 1, At, B1); PG8_BAR; PG8_SCHED;
            PG8_LDA(At, 1, 1); PG8_STAGE(PG8_SB(1, 0), b3, voffB); PG8_STAGE(PG8_SB(1, 1), b3 + hstepB, voffB); PG8_STAGE(PG8_SA(1, 0), a3, voffA);
            PG8_WAIT_V(8); PG8_WAIT_L(0); PG8_BAR; PG8_MMA(1, 0, At, B0); PG8_MMA(1, 1, At, B1); PG8_BAR; PG8_SCHED;
        }
        if constexpr (FP8) asm volatile("s_nop 7\n\ts_nop 7\n\ts_nop 7" ::: "memory");
        if constexpr (ALIGN_EPI) { if (wr == 0) PG8_BAR; }
        if constexpr (Epi::ROWSCALE) {
            static_assert(ALIGN_EPI, "row-scale table needs the aligned epilogue");
            asm volatile("s_waitcnt vmcnt(0)" : "+v"(rv) :: "memory");
            if (tid < 256) rsl[tid] = 1.0f / sqrtf((float)rv * (RS_INV / D) + EPS);
            PG8_WAIT_L(0); PG8_BAR; }
        E(acc, cur, wr, wc, fr, fq, rsl);
        if (!has_next) break;
        if (!BR3 || cur.br == 2) {
#pragma unroll
        for (int a = 0; a < 2; ++a)
#pragma unroll
            for (int b = 0; b < 2; ++b)
#pragma unroll
                for (int m = 0; m < 4; ++m)
#pragma unroll
                    for (int n = 0; n < 2; ++n) acc[a][b][m][n] = (f32x4){0.f, 0.f, 0.f, 0.f};
        }
        cur = nxt; cA = nA; cB = nB; ++ui;
        if constexpr (ALIGN_EPI) { if (wr == 1) PG8_BAR; }
    }
    PG8_WAIT_V(0);
    if constexpr (!ALIGN_EPI) { if (wr == 0) PG8_BAR; }
    PG8_BAR;
#undef PG8_SA
#undef PG8_SB
#undef PG8_STAGE
#undef PG8_LDA
#undef PG8_LDB
#undef PG8_MMA
#undef PG8_KOFF
#undef PG8_NT
#undef PG8_WAIT_V
#undef PG8_WAIT_L
#undef PG8_BAR
#undef PG8_SCHED
}
}

#define XB_TMO      128
#define XB_XCNT(j)  (256  + 64 * (j))
#define XB_XSUB(j)  (1280 + 64 * (j))
#define XB_XGEN(j)  (2304 + 64 * (j))
#define XB_TOP      3328
#define XB_TOPGEN   3392
#define XCD_BAR_WORDS 3456
#define XB_SPIN_CAP (1u << 18)
__device__ __forceinline__ unsigned xb_ld(unsigned* p)              { return __hip_atomic_load(p, __ATOMIC_RELAXED, __HIP_MEMORY_SCOPE_AGENT); }
__device__ __forceinline__ unsigned xb_add(unsigned* p, unsigned v) { return __hip_atomic_fetch_add(p, v, __ATOMIC_RELAXED, __HIP_MEMORY_SCOPE_AGENT); }
__device__ __forceinline__ unsigned xb_xcc_id() { return (unsigned)__builtin_amdgcn_s_getreg((3 << 11) | 20) & 0xFu; }
#define XB_SPIN(cond, bar) do { unsigned _sp = 0; while (cond) { __builtin_amdgcn_s_sleep(1); \
    if ((++_sp & 255u) == 0u) { if (xb_ld(&(bar)[XB_TMO])) break; if (_sp > XB_SPIN_CAP) { atomicAdd(&(bar)[XB_TMO], 1u); break; } } } } while (0)
struct XcdBarrier { unsigned* bar; unsigned x; volatile LAS unsigned* st; };
__device__ __forceinline__ XcdBarrier xcd_barrier_post(unsigned* bar, volatile LAS unsigned* st) {
    XcdBarrier b; b.bar = bar; b.x = xb_xcc_id(); b.st = st;
    if (threadIdx.x == 0) (void)xb_add(&bar[XB_XCNT(b.x)], 1u);
    return b;
}
__device__ __forceinline__ void xcd_barrier_complete(unsigned* bar, unsigned x, unsigned& nloc, unsigned& nx) {
    const unsigned G = gridDim.x * gridDim.y * gridDim.z;
    unsigned sum, cnt, mine, sp = 0u;
    for (;;) {
        sum = 0u; cnt = 0u; mine = 0u;
#pragma unroll
        for (unsigned j = 0; j < 16; ++j) { const unsigned c = xb_ld(&bar[XB_XCNT(j)]); sum += c; cnt += (c > 0u) ? 1u : 0u; mine = (j == x) ? c : mine; }
        if (sum == G) break;
        __builtin_amdgcn_s_sleep(1);
        if ((++sp & 255u) == 0u) { if (xb_ld(&bar[XB_TMO])) break; if (sp > XB_SPIN_CAP) { atomicAdd(&bar[XB_TMO], 1u); break; } }
    }
    nloc = mine > 0u ? mine : 1u; nx = cnt > 0u ? cnt : 1u;
}
__device__ __forceinline__ void xcd_barrier(const XcdBarrier& b) {
    asm volatile("s_waitcnt vmcnt(0)" ::: "memory");
    __syncthreads();
    if (threadIdx.x == 0) {
        unsigned* bar = b.bar;
        __builtin_amdgcn_s_waitcnt(0);
        unsigned nloc = b.st[0], nx = b.st[1];
        if (nloc == 0u) { xcd_barrier_complete(bar, b.x, nloc, nx); b.st[0] = nloc; b.st[1] = nx; }
        const unsigned old = xb_add(&bar[XB_XSUB(b.x)], 1u);
        const unsigned gen = old / nloc;
        if (old + 1u == (gen + 1u) * nloc) {
            __builtin_amdgcn_fence(__ATOMIC_RELEASE, "agent");
            asm volatile("s_waitcnt vmcnt(0)" ::: "memory");
            const unsigned og = xb_add(&bar[XB_TOP], 1u);
            const unsigned tg = og / nx;
            if (og + 1u == (tg + 1u) * nx) xb_add(&bar[XB_TOPGEN], 1u);
            else XB_SPIN(xb_ld(&bar[XB_TOPGEN]) == tg, bar);
            __builtin_amdgcn_fence(__ATOMIC_ACQUIRE, "agent");
            xb_add(&bar[XB_XGEN(b.x)], 1u);
            asm volatile("s_waitcnt vmcnt(0)" ::: "memory");
        } else {
            XB_SPIN(xb_ld(&bar[XB_XGEN(b.x)]) == gen, bar);
            __builtin_amdgcn_fence(__ATOMIC_ACQUIRE, "agent");
            asm volatile("s_waitcnt vmcnt(0)" ::: "memory");
        }
    }
    __syncthreads();
}

constexpr int RING_BYTES = 131072;
constexpr int LDS_MISC = RING_BYTES + 2048;
constexpr int LDS_BYTES = 147456;
struct Args {
    const float* in[18]; float* out; unsigned char* ws;
    int l_lo, l_hi, ph_lo, ph_hi;
};
struct Frame {
    LAS unsigned char* lds;
    int G, bid;
};
typedef const __attribute__((address_space(4))) Args* KArgsP;
__device__ __forceinline__ KArgsP kargs() { KArgsP p = (KArgsP)__builtin_amdgcn_kernarg_segment_ptr(); asm volatile("" : "+s"(p)); return p; }
#define A_IN(i) (kargs()->in[i])
#define A_WS(T, off) ((T*)(kargs()->ws + (off)))
#define A_OUT (kargs()->out)
#define P_x A_IN(0)
#define P_rel_bias A_IN(1)
#define P_norm1_g A_IN(2)
#define P_w_in A_IN(3)
#define P_q_norm_g A_IN(4)
#define P_k_norm_g A_IN(5)
#define P_gla_gate_up A_IN(6)
#define P_gla_gate_b A_IN(7)
#define P_gla_out_g A_IN(8)
#define P_sgu_ln_g A_IN(9)
#define P_sgu_ln_b A_IN(10)
#define P_sgu_w A_IN(11)
#define P_sgu_b A_IN(12)
#define P_w_branch A_IN(13)
#define P_w_out A_IN(14)
#define P_norm2_g A_IN(15)
#define P_w_ffn_in A_IN(16)
#define P_w_ffn_out A_IN(17)
#define P_WIN A_WS(bf16_t, WS_WIN)
#define P_W8 A_WS(unsigned char, WS_W8)
#define P_XB8 A_WS(unsigned char, WS_XB8)
#define P_WBR A_WS(bf16_t, WS_WBR)
#define P_WO A_WS(bf16_t, WS_WO)
#define P_WFI A_WS(bf16_t, WS_WFI)
#define P_WFO A_WS(bf16_t, WS_WFO)
#define P_XN A_WS(bf16_t, WS_XN)
#define P_Y A_WS(bf16_t, WS_Y)
#define P_OMIX A_WS(bf16_t, WS_OMIX)
#define P_Z A_WS(bf16_t, WS_Z)
#define P_H A_WS(bf16_t, WS_Z)
#define P_SP A_WS(bf16_t, WS_SP)
#define P_QT A_WS(bf16_t, WS_QT)
#define P_KT A_WS(bf16_t, WS_KT)
#define P_AO ((bf16_t*)((unsigned char*)A_OUT + OUT_AO))
#define P_SL ((bf16_t*)((unsigned char*)A_OUT + OUT_SL))
#define P_DL A_WS(float, WS_DL)
#define P_LSE A_WS(float, WS_LSE)
#define P_out A_OUT
#define P_RS1 A_WS(rs_t, WS_RS1)
#define P_RS2 A_WS(rs_t, WS_RS2)

template <bool FP8OUT, class SrcCol>
__device__ __forceinline__ void transpose_item(const float* W, int ldw, void* WTv, int K, LAS float* scr, int item, int nblk, int lane, const float* gain, SrcCol srccol) {
    const int kb = item / nblk, nb = item % nblk, k0 = 64 * kb, n0 = 32 * nb;
    const int nq = lane & 7, kr = lane >> 3, sc = srccol(n0 + 4 * nq);
    f32x4 v[8]; float gk[8];
#pragma unroll
    for (int i = 0; i < 8; ++i) { const int kk = 8 * i + kr; v[i] = sc >= 0 ? *(const f32x4*)(W + (size_t)(k0 + kk) * ldw + sc) : (f32x4){0.f, 0.f, 0.f, 0.f}; gk[i] = gain ? gain[k0 + kk] : 1.0f; }
#pragma unroll
    for (int i = 0; i < 8; ++i) { const int kk = 8 * i + kr; LAS float* d = scr + kk * 33 + 4 * nq; d[0] = v[i].x * gk[i]; d[1] = v[i].y * gk[i]; d[2] = v[i].z * gk[i]; d[3] = v[i].w * gk[i]; }
    LDS_WAIT(); asm volatile("" ::: "memory");
    const int c = lane & 7;
#pragma unroll
    for (int j = 0; j < 4; ++j) { const int n = (lane >> 3) + 8 * j; const LAS float* s = scr + (8 * c) * 33 + n;
        if constexpr (FP8OUT) { u32x2 o; o.x = 0u; o.y = 0u;
            o.x = __builtin_amdgcn_cvt_pk_fp8_f32(s[0 * 33] * W8_SCALE, s[1 * 33] * W8_SCALE, o.x, false); o.x = __builtin_amdgcn_cvt_pk_fp8_f32(s[2 * 33] * W8_SCALE, s[3 * 33] * W8_SCALE, o.x, true);
            o.y = __builtin_amdgcn_cvt_pk_fp8_f32(s[4 * 33] * W8_SCALE, s[5 * 33] * W8_SCALE, o.y, false); o.y = __builtin_amdgcn_cvt_pk_fp8_f32(s[6 * 33] * W8_SCALE, s[7 * 33] * W8_SCALE, o.y, true);
            *(u32x2*)((unsigned char*)WTv + (size_t)(n0 + n) * K + k0 + 8 * c) = o; }
        else { u32x4 o; o.x = cvt_pk_bf16(s[0 * 33], s[1 * 33]); o.y = cvt_pk_bf16(s[2 * 33], s[3 * 33]); o.z = cvt_pk_bf16(s[4 * 33], s[5 * 33]); o.w = cvt_pk_bf16(s[6 * 33], s[7 * 33]);
            *(u32x4*)((bf16_t*)WTv + (size_t)(n0 + n) * K + k0 + 8 * c) = o; } }
    LDS_WAIT(); asm volatile("" ::: "memory");
}
__device__ __forceinline__ void cast_rows(Frame& F, const float* x, bf16_t* xb, rs_t* rs, unsigned char* xb8) {
    const int tid_ = opq_tid(), lane = tid_ & 63, wave = __builtin_amdgcn_readfirstlane(tid_ >> 6);
    const int gw = F.bid * NWAVES + wave, NGW = F.G * NWAVES;
    for (int m = gw; m < M; m += NGW) {
        const f32x4* xr = (const f32x4*)(x + (size_t)m * D) + lane;
        f32x4 v[8]; float s = 0.f;
#pragma unroll
        for (int j = 0; j < 8; ++j) { v[j] = xr[64 * j]; s += (v[j].x * v[j].x + v[j].y * v[j].y) + (v[j].z * v[j].z + v[j].w * v[j].w); }
        s = wave_sum(s);
        u32x2* o8 = (u32x2*)(xb + (size_t)m * D) + lane;
#pragma unroll
        for (int j = 0; j < 8; ++j) { u32x2 w; w.x = cvt_pk_bf16(v[j].x, v[j].y); w.y = cvt_pk_bf16(v[j].z, v[j].w); o8[64 * j] = w; }
        unsigned* o4 = (unsigned*)(xb8 + (size_t)m * D) + lane;
#pragma unroll
        for (int j = 0; j < 8; ++j) { unsigned q8 = 0u; q8 = __builtin_amdgcn_cvt_pk_fp8_f32(v[j].x, v[j].y, q8, false); q8 = __builtin_amdgcn_cvt_pk_fp8_f32(v[j].z, v[j].w, q8, true); o4[64 * j] = q8; }
        if (lane == 0) rs[m] = (rs_t)(s * RS_SCALE + 0.5f);
    }
}
struct TJob { const float* src; const float* gp; unsigned char* dst; int ldw, K; bool valid, fp8; };
__device__ __forceinline__ void tj_load(const TJob& j, f32x4 (&v)[8], float (&gk)[8]) {
#pragma unroll
    for (int i = 0; i < 8; ++i) { v[i] = j.valid ? *(const f32x4*)(j.src + (size_t)(8 * i) * j.ldw) : (f32x4){0.f, 0.f, 0.f, 0.f}; gk[i] = j.gp ? j.gp[8 * i] : 1.0f; }
}
__device__ __forceinline__ void tj_process(const TJob& j, const f32x4 (&v)[8], const float (&gk)[8], LAS float* scr, int lane) {
    const int nq = lane & 7, kr = lane >> 3;
#pragma unroll
    for (int i = 0; i < 8; ++i) { const int kk = 8 * i + kr; LAS float* d = scr + kk * 33 + 4 * nq; d[0] = v[i].x * gk[i]; d[1] = v[i].y * gk[i]; d[2] = v[i].z * gk[i]; d[3] = v[i].w * gk[i]; }
    LDS_WAIT(); asm volatile("" ::: "memory");
    const int c = lane & 7;
#pragma unroll
    for (int q = 0; q < 4; ++q) { const int n = (lane >> 3) + 8 * q; const LAS float* s = scr + (8 * c) * 33 + n;
        if (j.fp8) { u32x2 o; o.x = 0u; o.y = 0u;
            o.x = __builtin_amdgcn_cvt_pk_fp8_f32(s[0 * 33] * W8_SCALE, s[1 * 33] * W8_SCALE, o.x, false); o.x = __builtin_amdgcn_cvt_pk_fp8_f32(s[2 * 33] * W8_SCALE, s[3 * 33] * W8_SCALE, o.x, true);
            o.y = __builtin_amdgcn_cvt_pk_fp8_f32(s[4 * 33] * W8_SCALE, s[5 * 33] * W8_SCALE, o.y, false); o.y = __builtin_amdgcn_cvt_pk_fp8_f32(s[6 * 33] * W8_SCALE, s[7 * 33] * W8_SCALE, o.y, true);
            *(u32x2*)(j.dst + (size_t)(8 * q) * j.K) = o; }
        else { u32x4 o; o.x = cvt_pk_bf16(s[0 * 33], s[1 * 33]); o.y = cvt_pk_bf16(s[2 * 33], s[3 * 33]); o.z = cvt_pk_bf16(s[4 * 33], s[5 * 33]); o.w = cvt_pk_bf16(s[6 * 33], s[7 * 33]);
            *(u32x4*)(j.dst + (size_t)(16 * q) * j.K) = o; } }
    LDS_WAIT(); asm volatile("" ::: "memory");
}
__device__ __forceinline__ void p0_convert(Frame& F, int l) {
    const int tid_ = opq_tid(), lane = tid_ & 63, wave = __builtin_amdgcn_readfirstlane(tid_ >> 6);
    LAS float* scr = (LAS float*)(F.lds + wave * 16384);
    const int gw = F.bid * NWAVES + wave, NGW = F.G * NWAVES;
    constexpr int I_IN = (D / 64) * (NB / 32), I_8 = (D / 64) * (N8 / 32), I_BR = (D / 64) * (D / 32), I_O = I_BR, I_FI = (D / 64) * (NFI / 32), I_FO = (DFF / 64) * (D / 32);
    constexpr int NITEMS = I_IN + I_8 + I_BR + I_O + I_FI + I_FO;
    const int nq = lane & 7, kr = lane >> 3;
    auto describe = [&](int it) -> TJob {
        const float* w_in = P_w_in + (size_t)l * D * DIN; const float* w_br = P_w_branch + (size_t)l * D * D; const float* w_o = P_w_out + (size_t)l * D * D;
        const float* w_fi = P_w_ffn_in + (size_t)l * D * NFI; const float* w_fo = P_w_ffn_out + (size_t)l * DFF * D;
        auto fin = [&](const float* W, int ldw, void* WT, int K, int kb, int nb, const float* gain, int sc, bool fp8) -> TJob {
            TJob j; const int k0 = 64 * kb, n0 = 32 * nb;
            j.src = W + (size_t)(k0 + kr) * ldw + sc; j.gp = gain ? gain + k0 + kr : nullptr; j.ldw = ldw; j.K = K; j.valid = sc >= 0; j.fp8 = fp8;
            j.dst = (unsigned char*)WT + ((size_t)(n0 + (lane >> 3)) * K + k0 + 8 * (lane & 7)) * (fp8 ? 1 : 2); return j; };
        int r = it;
        if (r < I_IN) { const int nb = r % (NB / 32), n = 32 * nb + 4 * nq;
            return fin(w_in, DIN, P_WIN, D, r / (NB / 32), nb, P_norm1_g + l * D, n < 1536 ? 4608 + n : (n < 3072 ? 6160 + (n - 1536) : (n < 3088 ? 6144 + (n - 3072) : -1)), false); } r -= I_IN;
        if (r < I_8) { const int nb = r % (N8 / 32), n = 32 * nb + 4 * nq;
            return fin(w_in, DIN, P_W8, D, r / (N8 / 32), nb, P_norm1_g + l * D, n < 4608 ? n : 7696 + (n - 4608), true); } r -= I_8;
        if (r < I_BR) { const int nb = r % (D / 32); return fin(w_br, D, P_WBR, D, r / (D / 32), nb, nullptr, 32 * nb + 4 * nq, false); } r -= I_BR;
        if (r < I_O) { const int nb = r % (D / 32); return fin(w_o, D, P_WO, D, r / (D / 32), nb, nullptr, 32 * nb + 4 * nq, false); } r -= I_O;
        if (r < I_FI) { const int nb = r % (NFI / 32), n = 32 * nb + 4 * nq, t = n >> 8, jj = n & 255;
            return fin(w_fi, NFI, P_WFI, D, r / (NFI / 32), nb, P_norm2_g + l * D, jj < 128 ? 128 * t + jj : DFF + 128 * t + (jj - 128), false); } r -= I_FI;
        { const int nb = r % (D / 32); return fin(w_fo, D, P_WFO, DFF, r / (D / 32), nb, nullptr, 32 * nb + 4 * nq, false); }
    };
    f32x4 vA[8], vB[8]; float gA[8], gB[8]; TJob jA, jB;
    int it = gw;
    if (it < NITEMS) { jA = describe(it); tj_load(jA, vA, gA); }
    for (; it < NITEMS; it += 2 * NGW) {
        const bool hasB = it + NGW < NITEMS;
        if (hasB) { jB = describe(it + NGW); tj_load(jB, vB, gB); }
        tj_process(jA, vA, gA, scr, lane);
        if (it + 2 * NGW < NITEMS) { jA = describe(it + 2 * NGW); tj_load(jA, vA, gA); }
        if (hasB) tj_process(jB, vB, gB, scr, lane);
    }
}

__device__ __forceinline__ unsigned off_b(unsigned row, unsigned ch) { return 256u * row + 16u * (ch ^ (((row & 3u) << 2) | ((row >> 2) & 3u))); }
__device__ __forceinline__ s16x4 tr16(const LAS unsigned char* p) {
    typedef short v4i16_t __attribute__((ext_vector_type(4)));
    return __builtin_bit_cast(s16x4, __builtin_amdgcn_ds_read_tr16_b64_v4i16((LAS v4i16_t*)p));
}
__device__ __forceinline__ bf16x8 cat8(s16x4 a, s16x4 b) { return (bf16x8){a[0], a[1], a[2], a[3], b[0], b[1], b[2], b[3]}; }
__device__ __forceinline__ int t5_bucket(int td) {
    if (td < 16) return td;
    int b = 16;
    b += td >= 22; b += td >= 30; b += td >= 40; b += td >= 54; b += td >= 73; b += td >= 99; b += td >= 134; b += td >= 182;
    b += td >= 246; b += td >= 332; b += td >= 450; b += td >= 609; b += td >= 825; b += td >= 1117; b += td >= 1513;
    return b;
}
constexpr int ATT_K = 0, ATT_V = 65536, ATT_BIAS = 131072;
__device__ __forceinline__ void attn_norm_store(LAS unsigned char* Kimg, LAS unsigned char* Vimg, int row, int ch, u32x4 kv, u32x4 vv, f32x4 gk0, f32x4 gk1) {
    float kf[8] = {bflo(kv.x), bfhi(kv.x), bflo(kv.y), bfhi(kv.y), bflo(kv.z), bfhi(kv.z), bflo(kv.w), bfhi(kv.w)};
    float ss = 0.f;
#pragma unroll
    for (int j = 0; j < 8; ++j) ss += kf[j] * kf[j];
    ss += __shfl_xor(ss, 1); ss += __shfl_xor(ss, 2); ss += __shfl_xor(ss, 4); ss += __shfl_xor(ss, 8);
    const float rs = 1.0f / sqrtf(ss * (1.f / 128.f) + EPS);
    u32x4 ko; ko.x = cvt_pk_bf16(kf[0] * rs * gk0.x, kf[1] * rs * gk0.y); ko.y = cvt_pk_bf16(kf[2] * rs * gk0.z, kf[3] * rs * gk0.w);
    ko.z = cvt_pk_bf16(kf[4] * rs * gk1.x, kf[5] * rs * gk1.y); ko.w = cvt_pk_bf16(kf[6] * rs * gk1.z, kf[7] * rs * gk1.w);
    const unsigned o = off_b((unsigned)row, (unsigned)ch);
    *(LAS u32x4*)(Kimg + o) = ko; *(LAS u32x4*)(Vimg + o) = vv;
}
__device__ __forceinline__ void attn_seg(Frame& F, int seg, int l) {
    const int rnb = seg & 7, h = (seg >> 3) & 3, bg = seg >> 5, g = bg % 3, b = bg / 3;
    const int dsh = 2 * g, dil = 1 << dsh, nb = 32 >> dsh;
    const bf16_t* Zb = P_Z + (size_t)b * SEQ * NZ;
    const int qcol = g * 512 + h * 128;
    LAS unsigned char* Kimg = F.lds + ATT_K; LAS unsigned char* Vimg = F.lds + ATT_V; LAS float* biasT = (LAS float*)(F.lds + ATT_BIAS);
    const int tid = opq_tid(), lane = tid & 63, w = __builtin_amdgcn_readfirstlane(tid >> 6), fr = lane & 15, fq = lane >> 4;
    if (tid < 192) { const int d = tid - 32; biasT[tid] = (d >= 0 && d <= 128) ? P_rel_bias[t5_bucket(d << dsh) * 12 + g * 4 + h] : -3.0e38f; }
    LAS float* gqL = biasT + 256;
    if (tid >= 256 && tid < 384) gqL[tid - 256] = P_q_norm_g[l * 128 + (tid - 256)];
    const int ch = tid & 15, srow = tid >> 4;
    const f32x4 gk0 = *(const f32x4*)(P_k_norm_g + l * 128 + ch * 8), gk1 = *(const f32x4*)(P_k_norm_g + l * 128 + ch * 8 + 4);
    u32x4 kc[4], vc[4];
    {
        const int rn = 4 * rnb, r = rn / nb, n = rn % nb;
#pragma unroll
        for (int it = 0; it < 4; ++it) { const bf16_t* p = Zb + (size_t)((128 * n + it * 32 + srow) * dil + r) * NZ + qcol + ch * 8; kc[it] = *(const u32x4*)(p + ZK); vc[it] = *(const u32x4*)(p + ZV); }
    }
#pragma unroll 1
    for (int pos = 0; pos < 4; ++pos) {
        const int rn = 4 * rnb + pos, r = rn / nb, n = rn % nb;
        const int cs = (n & 1) << 7, ps = cs ^ 128;
        const int qi = 16 * w + fr, qtok = (128 * n + qi) * dil + r;
        const size_t qrow = (size_t)b * SEQ + qtok;
        u32x4 qv[4];
        { const bf16_t* qp = P_Z + qrow * NZ + ZQ + qcol + 8 * fq;
#pragma unroll
          for (int ks = 0; ks < 4; ++ks) qv[ks] = *(const u32x4*)(qp + 32 * ks); }
        if (n == 0) {
#pragma unroll
            for (int it = 0; it < 4; ++it) { const unsigned o = off_b((unsigned)(ps + it * 32 + srow), (unsigned)ch); *(LAS u32x4*)(Kimg + o) = (u32x4){0u, 0u, 0u, 0u}; *(LAS u32x4*)(Vimg + o) = (u32x4){0u, 0u, 0u, 0u}; }
        } else if (pos == 0) {
            u32x4 kp[4], vp[4];
#pragma unroll
            for (int it = 0; it < 4; ++it) { const bf16_t* p = Zb + (size_t)((128 * (n - 1) + it * 32 + srow) * dil + r) * NZ + qcol + ch * 8; kp[it] = *(const u32x4*)(p + ZK); vp[it] = *(const u32x4*)(p + ZV); }
#pragma unroll
            for (int it = 0; it < 4; ++it) attn_norm_store(Kimg, Vimg, ps + it * 32 + srow, ch, kp[it], vp[it], gk0, gk1);
        }
#pragma unroll
        for (int it = 0; it < 4; ++it) attn_norm_store(Kimg, Vimg, cs + it * 32 + srow, ch, kc[it], vc[it], gk0, gk1);
        if (pos < 3) {
            const int rn2 = rn + 1, r2 = rn2 / nb, n2 = rn2 % nb;
#pragma unroll
            for (int it = 0; it < 4; ++it) { const bf16_t* p = Zb + (size_t)((128 * n2 + it * 32 + srow) * dil + r2) * NZ + qcol + ch * 8; kc[it] = *(const u32x4*)(p + ZK); vc[it] = *(const u32x4*)(p + ZV); }
        }
        bf16x8 qf[4];
        {
            float ss = 0.f;
#pragma unroll
            for (int ks = 0; ks < 4; ++ks) {
                const float a0 = bflo(qv[ks].x), a1 = bfhi(qv[ks].x), a2 = bflo(qv[ks].y), a3 = bfhi(qv[ks].y), a4 = bflo(qv[ks].z), a5 = bfhi(qv[ks].z), a6 = bflo(qv[ks].w), a7 = bfhi(qv[ks].w);
                ss += (a0 * a0 + a1 * a1) + (a2 * a2 + a3 * a3) + (a4 * a4 + a5 * a5) + (a6 * a6 + a7 * a7); }
            ss += __shfl_xor(ss, 16); ss += __shfl_xor(ss, 32);
            const float rs = (1.0f / sqrtf(ss * (1.f / 128.f) + EPS)) * 0.08838834764831845f;
#pragma unroll
            for (int ks = 0; ks < 4; ++ks) { const f32x4 g0 = *(const LAS f32x4*)(gqL + 32 * ks + 8 * fq), g1 = *(const LAS f32x4*)(gqL + 32 * ks + 8 * fq + 4);
                u32x4 o; o.x = cvt_pk_bf16(bflo(qv[ks].x) * rs * g0.x, bfhi(qv[ks].x) * rs * g0.y); o.y = cvt_pk_bf16(bflo(qv[ks].y) * rs * g0.z, bfhi(qv[ks].y) * rs * g0.w);
                o.z = cvt_pk_bf16(bflo(qv[ks].z) * rs * g1.x, bfhi(qv[ks].z) * rs * g1.y); o.w = cvt_pk_bf16(bflo(qv[ks].w) * rs * g1.z, bfhi(qv[ks].w) * rs * g1.w);
                qf[ks] = __builtin_bit_cast(bf16x8, o); }
        }
        WG_SYNC();
        const int kb0 = w >> 1;
        f32x4 s[5][2];
#pragma unroll
        for (int kbi = 0; kbi < 5; ++kbi)
#pragma unroll
            for (int hb = 0; hb < 2; ++hb) {
                const unsigned krow = (unsigned)((32 * (kb0 + kbi) + 8 * (fr >> 2) + (fr & 3) + 4 * hb) ^ ps);
                f32x4 a = (f32x4){0.f, 0.f, 0.f, 0.f};
#pragma unroll
                for (int ks = 0; ks < 4; ++ks) { const bf16x8 kfr = *(const LAS bf16x8*)(Kimg + off_b(krow, (unsigned)(4 * ks + fq))); a = __builtin_amdgcn_mfma_f32_16x16x32_bf16(kfr, qf[ks], a, 0, 0, 0); }
                s[kbi][hb] = a;
            }
        float mx = -3.0e38f;
        const LAS float* bt = biasT + (qi + 160 - 32 * kb0 - 8 * fq);
        float bv[5][2][4];
#pragma unroll
        for (int kbi = 0; kbi < 5; ++kbi)
#pragma unroll
            for (int hb = 0; hb < 2; ++hb)
#pragma unroll
                for (int i = 0; i < 4; ++i) bv[kbi][hb][i] = bt[-(32 * kbi + 4 * hb + i)];
#pragma unroll
        for (int kbi = 0; kbi < 5; ++kbi) {
            const float dm = ((n == 0) && (kb0 + kbi < 4)) ? -3.0e38f : 0.f;
#pragma unroll
            for (int hb = 0; hb < 2; ++hb)
#pragma unroll
                for (int i = 0; i < 4; ++i) {
                    const float v = (s[kbi][hb][i] + bv[kbi][hb][i]) + dm;
                    s[kbi][hb][i] = v; mx = fmaxf(mx, v);
                }
        }
        mx = fmaxf(mx, __shfl_xor(mx, 16)); mx = fmaxf(mx, __shfl_xor(mx, 32));
        float sum = 0.f; bf16x8 pf[5];
#pragma unroll
        for (int kbi = 0; kbi < 5; ++kbi) {
            float p[8];
#pragma unroll
            for (int hb = 0; hb < 2; ++hb)
#pragma unroll
                for (int i = 0; i < 4; ++i) { const float e = __expf(s[kbi][hb][i] - mx); p[4 * hb + i] = e; sum += e; }
            u32x4 o; o.x = cvt_pk_bf16(p[0], p[1]); o.y = cvt_pk_bf16(p[2], p[3]); o.z = cvt_pk_bf16(p[4], p[5]); o.w = cvt_pk_bf16(p[6], p[7]);
            pf[kbi] = __builtin_bit_cast(bf16x8, o);
        }
        sum += __shfl_xor(sum, 16); sum += __shfl_xor(sum, 32);
        const float inv = 1.0f / sum;
        bf16_t* op = P_AO + ((size_t)g * M + qrow) * 512 + h * 128 + 4 * fq;
        const unsigned tq = (unsigned)((lane & 15) >> 2), tp = (unsigned)(lane & 3);
#pragma unroll
        for (int c = 0; c < 8; ++c) {
            f32x4 o = (f32x4){0.f, 0.f, 0.f, 0.f};
#pragma unroll
            for (int kbi = 0; kbi < 5; ++kbi) {
                const unsigned r0 = ((unsigned)(32 * (kb0 + kbi) + 8 * fq) + tq) ^ (unsigned)ps;
                const s16x4 lo = tr16(Vimg + off_b(r0, (unsigned)(2 * c) + (tp >> 1)) + 8u * (tp & 1u));
                const s16x4 hi = tr16(Vimg + off_b(r0 + 4u, (unsigned)(2 * c) + (tp >> 1)) + 8u * (tp & 1u));
                o = __builtin_amdgcn_mfma_f32_16x16x32_bf16(cat8(lo, hi), pf[kbi], o, 0, 0, 0);
            }
            u32x2 wv; wv.x = cvt_pk_bf16(o[0] * inv, o[1] * inv); wv.y = cvt_pk_bf16(o[2] * inv, o[3] * inv);
            *(u32x2*)(op + 16 * c) = wv;
        }
        if (fq == 0) P_LSE[((size_t)g * M + qrow) * 4 + h] = mx + __logf(sum);
        WG_SYNC();
    }
}

constexpr int G1_P = 208;
constexpr int G1_QS = 0, G1_KS = 64 * G1_P, G1_KH = 2 * 64 * G1_P;
constexpr int G1_V = 3 * 64 * G1_P;
constexpr int G1_V_P = 400;
constexpr int G1_GL = G1_V + 64 * G1_V_P;
constexpr int G1_TOT = G1_GL + 4096;
constexpr int G1_END = G1_TOT + 1536;
__device__ __forceinline__ bf16x8 tr_frag(const LAS unsigned char* img, int pitch, int row0, int col0, int lane) {
    const int g = lane >> 4, q = (lane & 15) >> 2, p = lane & 3;
    const LAS unsigned char* a = img + (row0 + 8 * g + q) * pitch + (col0 + 4 * p) * 2;
    return cat8(tr16(a), tr16(a + 4 * pitch));
}
__device__ __forceinline__ void gla1_unit(Frame& F, int unit, int l) {
    const int h = unit & 3, c = (unit >> 2) & 63, b = unit >> 8;
    const size_t row0 = (size_t)b * SEQ + 64 * c;
    const bf16_t* Zr = P_Z + row0 * NZ;
    const int tid = opq_tid(), lane = tid & 63, w = __builtin_amdgcn_readfirstlane(tid >> 6);
    LAS unsigned char* QS = F.lds + G1_QS; LAS unsigned char* KS = F.lds + G1_KS; LAS unsigned char* KH = F.lds + G1_KH; LAS unsigned char* VI = F.lds + G1_V;
    LAS float* GLs = (LAS float*)(F.lds + G1_GL); LAS float* TOT = (LAS float*)(F.lds + G1_TOT);
    const int k = tid & 127, tg = tid >> 7;
    const bool act = k < GLA_DK;
    const int kc = act ? k : 0;
    {
        const int t = tid >> 3, j2 = (tid & 7) * 2; const unsigned gw2 = *(const unsigned*)(Zr + (size_t)t * NZ + ZGL + j2);
        u32x4 vv[3], qq[2], kk[2];
#pragma unroll
        for (int i = 0; i < 3; ++i) { const int idx = tid + 512 * i, sr = idx / 24, ch = idx % 24; vv[i] = *(const u32x4*)(Zr + (size_t)sr * NZ + ZBV + h * GLA_DV + ch * 8); }
#pragma unroll
        for (int i = 0; i < 2; ++i) { const int idx = tid + 512 * i; if (idx < 768) { const int sr = idx / 12, ch = idx % 12; const bf16_t* p = Zr + (size_t)sr * NZ + h * GLA_DK + ch * 8; qq[i] = *(const u32x4*)(p + ZBQ); kk[i] = *(const u32x4*)(p + ZBK); } }
        GLs[t * 16 + j2] = bflo(gw2); GLs[t * 16 + j2 + 1] = bfhi(gw2);
#pragma unroll
        for (int i = 0; i < 3; ++i) { const int idx = tid + 512 * i, sr = idx / 24, ch = idx % 24; *(LAS u32x4*)(VI + sr * G1_V_P + ch * 16) = vv[i]; }
#pragma unroll
        for (int i = 0; i < 2; ++i) { const int idx = tid + 512 * i; if (idx < 768) { const int sr = idx / 12, ch = idx % 12; *(LAS u32x4*)(QS + sr * G1_P + ch * 16) = qq[i]; *(LAS u32x4*)(KS + sr * G1_P + ch * 16) = kk[i]; } }
    }
    float wu[16];
#pragma unroll
    for (int j = 0; j < 16; ++j) wu[j] = P_gla_gate_up[((size_t)l * 16 + j) * 384 + h * GLA_DK + kc];
    const float bg = P_gla_gate_b[l * 384 + h * GLA_DK + kc];
    WG_SYNC();
    float bcum[16];
    {
        float run = 0.f;
#pragma unroll
        for (int i = 0; i < 16; ++i) {
            const LAS f32x4* gp = (const LAS f32x4*)(GLs + (16 * tg + i) * 16);
            const f32x4 g0 = gp[0], g1 = gp[1], g2 = gp[2], g3 = gp[3];
            float xg = bg + g0.x * wu[0] + g0.y * wu[1] + g0.z * wu[2] + g0.w * wu[3] + g1.x * wu[4] + g1.y * wu[5] + g1.z * wu[6] + g1.w * wu[7]
                     + g2.x * wu[8] + g2.y * wu[9] + g2.z * wu[10] + g2.w * wu[11] + g3.x * wu[12] + g3.y * wu[13] + g3.z * wu[14] + g3.w * wu[15];
            const float ls = fminf(xg, 0.f) - __logf(1.0f + __expf(-fabsf(xg)));
            run += ls * (1.0f / 16.0f); bcum[i] = run;
        }
        if (act) TOT[tg * GLA_DK + k] = run;
    }
    WG_SYNC();
    {
        float offs = 0.f, blast = 0.f;
#pragma unroll
        for (int q = 0; q < 4; ++q) { const float tv = TOT[q * GLA_DK + kc]; blast += tv; offs += q < tg ? tv : 0.f; }
        if (act) {
            if (tg == 0) P_DL[(size_t)unit * GLA_DK + k] = __expf(blast);
#pragma unroll
            for (int i = 0; i < 16; ++i) {
                const int t = 16 * tg + i; const float bb = bcum[i] + offs;
                LAS bf16_t* qa = (LAS bf16_t*)(QS + t * G1_P + k * 2); LAS bf16_t* ka = (LAS bf16_t*)(KS + t * G1_P + k * 2);
                const float qv = bflo((unsigned)*qa), kv = bflo((unsigned)*ka);
                *qa = (bf16_t)(cvt_pk_bf16(qv * 0.10206207261596575f * __expf(bb), 0.f) & 0xffffu);
                *ka = (bf16_t)(cvt_pk_bf16(kv * __expf(-bb), 0.f) & 0xffffu);
                *(LAS bf16_t*)(KH + t * G1_P + k * 2) = (bf16_t)(cvt_pk_bf16(kv * __expf(blast - bb), 0.f) & 0xffffu);
            }
        }
    }
    WG_SYNC();
    {
        bf16_t* QTp = P_QT; bf16_t* KTp = P_KT;
#pragma unroll
        for (int i = 0; i < 2; ++i) { const int idx = tid + 512 * i; if (idx < 768) { const int sr = idx / 12, ch = idx % 12; const size_t go = (row0 + sr) * 384 + h * GLA_DK + ch * 8;
            *(u32x4*)(QTp + go) = *(const LAS u32x4*)(QS + sr * G1_P + ch * 16); *(u32x4*)(KTp + go) = *(const LAS u32x4*)(KS + sr * G1_P + ch * 16); } }
    }
    bf16_t* SLu = P_SL + (size_t)unit * GLA_DV * GLA_DK;
    const int fr = lane & 15, fq = lane >> 4;
#pragma unroll 3
    for (int j = 0; j < 9; ++j) {
        const int tau = 9 * w + j, vt = tau / 6, kt = tau % 6;
        f32x4 a = (f32x4){0.f, 0.f, 0.f, 0.f};
#pragma unroll
        for (int ks = 0; ks < 2; ++ks) {
            const bf16x8 af = tr_frag(VI, G1_V_P, 32 * ks, 16 * vt, lane);
            const bf16x8 bfv = tr_frag(KH, G1_P, 32 * ks, 16 * kt, lane);
            a = __builtin_amdgcn_mfma_f32_16x16x32_bf16(bfv, af, a, 0, 0, 0);
        }
        { u32x2 wv; wv.x = cvt_pk_bf16(a[0], a[1]); wv.y = cvt_pk_bf16(a[2], a[3]); *(u32x2*)(SLu + (size_t)(16 * vt + fr) * GLA_DK + 16 * kt + 4 * fq) = wv; }
    }
    WG_SYNC();
}
__device__ __forceinline__ void gla_scan(Frame& F) {
    const int ntask = BATCH * 4 * GLA_DV * 12;
    const bf16_t* SLp = P_SL; const float* DLp = P_DL; bf16_t* SPp = P_SP;
    for (int task = F.bid * NT + opq_tid(); task < ntask; task += F.G * NT) {
        const int ko = task % 12, vd = (task / 12) % GLA_DV, bh = task / (12 * GLA_DV), h = bh & 3, b = bh >> 2;
        float st[8];
#pragma unroll
        for (int j = 0; j < 8; ++j) st[j] = 0.f;
#pragma unroll 4
        for (int c = 0; c < NCHK; ++c) {
            const size_t unit = ((size_t)b * NCHK + c) * 4 + h;
            const size_t e = (unit * GLA_DV + vd) * GLA_DK + ko * 8;
            const u32x4 sw = *(const u32x4*)(SLp + e); const f32x4 s0 = (f32x4){bflo(sw.x), bfhi(sw.x), bflo(sw.y), bfhi(sw.y)}, s1 = (f32x4){bflo(sw.z), bfhi(sw.z), bflo(sw.w), bfhi(sw.w)};
            const f32x4 d0 = *(const f32x4*)(DLp + unit * GLA_DK + ko * 8), d1 = *(const f32x4*)(DLp + unit * GLA_DK + ko * 8 + 4);
            u32x4 o; o.x = cvt_pk_bf16(st[0], st[1]); o.y = cvt_pk_bf16(st[2], st[3]); o.z = cvt_pk_bf16(st[4], st[5]); o.w = cvt_pk_bf16(st[6], st[7]);
            *(u32x4*)(SPp + e) = o;
            st[0] = d0.x * st[0] + s0.x; st[1] = d0.y * st[1] + s0.y; st[2] = d0.z * st[2] + s0.z; st[3] = d0.w * st[3] + s0.w;
            st[4] = d1.x * st[4] + s1.x; st[5] = d1.y * st[5] + s1.y; st[6] = d1.z * st[6] + s1.z; st[7] = d1.w * st[7] + s1.w;
        }
    }
}
constexpr int G3_V_P = 400;
__device__ __forceinline__ void gla3_unit(Frame& F, int unit, int l) {
    const int cp = unit & 31, h = (unit >> 5) & 3, b = unit >> 7;
    const int tid = opq_tid(), lane = tid & 63, w = __builtin_amdgcn_readfirstlane(tid >> 6), fr = lane & 15, fq = lane >> 4;
    const int cw = w >> 2, tt = w & 3, c = 2 * cp + cw;
    const size_t row0 = (size_t)b * SEQ + 64 * c;
    LAS unsigned char* VI = F.lds + cw * (64 * G3_V_P);
    u32x4 vreg[6];
    {
        const int lt = tid & 255; const bf16_t* Zr = P_Z + row0 * NZ + ZBV + h * GLA_DV;
#pragma unroll
        for (int i = 0; i < 6; ++i) { const int idx = lt + 256 * i, sr = idx / 24, ch = idx % 24; vreg[i] = *(const u32x4*)(Zr + (size_t)sr * NZ + ch * 8); }
    }
    bf16x8 qf[3];
    { const bf16_t* qp = P_QT + (row0 + 16 * tt + fr) * 384 + h * GLA_DK + 8 * fq;
#pragma unroll
      for (int ks = 0; ks < 3; ++ks) qf[ks] = *(const bf16x8*)(qp + 32 * ks); }
    bf16x8 pf[2];
    const int nblk = (tt >> 1) + 1;
#pragma unroll
    for (int blk = 0; blk < 2; ++blk) {
        u32x4 pw = (u32x4){0u, 0u, 0u, 0u};
        if (blk < nblk) {
            float p[8];
#pragma unroll
            for (int hb = 0; hb < 2; ++hb) {
                const int srow = 32 * blk + 8 * (fr >> 2) + (fr & 3) + 4 * hb;
                const bf16_t* kp = P_KT + (row0 + srow) * 384 + h * GLA_DK + 8 * fq;
                f32x4 a = (f32x4){0.f, 0.f, 0.f, 0.f};
#pragma unroll
                for (int ks = 0; ks < 3; ++ks) a = __builtin_amdgcn_mfma_f32_16x16x32_bf16(*(const bf16x8*)(kp + 32 * ks), qf[ks], a, 0, 0, 0);
#pragma unroll
                for (int i = 0; i < 4; ++i) { const int sidx = 32 * blk + 8 * fq + 4 * hb + i; p[4 * hb + i] = sidx <= 16 * tt + fr ? a[i] : 0.f; }
            }
            pw.x = cvt_pk_bf16(p[0], p[1]); pw.y = cvt_pk_bf16(p[2], p[3]); pw.z = cvt_pk_bf16(p[4], p[5]); pw.w = cvt_pk_bf16(p[6], p[7]);
        }
        pf[blk] = __builtin_bit_cast(bf16x8, pw);
    }
    const size_t gu = ((size_t)b * NCHK + c) * 4 + h;
    const bf16_t* SPu = P_SP + gu * GLA_DV * GLA_DK;
    f32x4 o[12];
#pragma unroll
    for (int vt = 0; vt < 12; ++vt) {
        f32x4 a = (f32x4){0.f, 0.f, 0.f, 0.f};
        const bf16_t* sp = SPu + (size_t)(16 * vt + fr) * GLA_DK + 8 * fq;
#pragma unroll
        for (int ks = 0; ks < 3; ++ks) a = __builtin_amdgcn_mfma_f32_16x16x32_bf16(*(const bf16x8*)(sp + 32 * ks), qf[ks], a, 0, 0, 0);
        o[vt] = a;
    }
    {
        const int lt = tid & 255;
#pragma unroll
        for (int i = 0; i < 6; ++i) { const int idx = lt + 256 * i, sr = idx / 24, ch = idx % 24; *(LAS u32x4*)(VI + sr * G3_V_P + ch * 16) = vreg[i]; }
    }
    WG_SYNC();
    float ss = 0.f;
#pragma unroll
    for (int vt = 0; vt < 12; ++vt) {
        f32x4 a = o[vt];
#pragma unroll
        for (int blk = 0; blk < 2; ++blk) { const bf16x8 vf = tr_frag(VI, G3_V_P, 32 * blk, 16 * vt, lane); a = __builtin_amdgcn_mfma_f32_16x16x32_bf16(vf, pf[blk], a, 0, 0, 0); }
        o[vt] = a; ss += (a[0] * a[0] + a[1] * a[1]) + (a[2] * a[2] + a[3] * a[3]);
    }
    ss += __shfl_xor(ss, 16); ss += __shfl_xor(ss, 32);
    const float rs = 1.0f / sqrtf(ss * (1.f / GLA_DV) + EPS);
    bf16_t* op = P_OMIX + (row0 + 16 * tt + fr) * D + 512 + h * GLA_DV + 4 * fq;
    const float* go = P_gla_out_g + l * GLA_DV + 4 * fq;
#pragma unroll
    for (int vt = 0; vt < 12; ++vt) { const f32x4 gv = *(const f32x4*)(go + 16 * vt);
        u32x2 wv; wv.x = cvt_pk_bf16(o[vt][0] * rs * gv.x, o[vt][1] * rs * gv.y); wv.y = cvt_pk_bf16(o[vt][2] * rs * gv.z, o[vt][3] * rs * gv.w);
        *(u32x2*)(op + 16 * vt) = wv; }
    WG_SYNC();
}

constexpr int SG_V_P = 400;
constexpr int SG_ST = 128 * SG_V_P;
__device__ __forceinline__ void sgu_unit(Frame& F, int unit, int l) {
    const int n = unit & 31, b = unit >> 5;
    const size_t row0 = (size_t)b * SEQ + 128 * n;
    const bf16_t* Zr = P_Z + row0 * NZ;
    const int tid = opq_tid(), lane = tid & 63, w = __builtin_amdgcn_readfirstlane(tid >> 6), fr = lane & 15, fq = lane >> 4;
    LAS unsigned char* VN = F.lds; LAS float* ST = (LAS float*)(F.lds + SG_ST);
    {
        const int t = tid >> 2, qd = tid & 3; const bf16_t* p = Zr + (size_t)t * NZ + ZCV + 192 * qd;
        float s1 = 0.f, s2 = 0.f;
#pragma unroll
        for (int hb = 0; hb < 2; ++hb) {
            u32x4 v[12];
#pragma unroll
            for (int c = 0; c < 12; ++c) v[c] = *(const u32x4*)(p + 96 * hb + 8 * c);
#pragma unroll
            for (int c = 0; c < 12; ++c) {
                const float a0 = gelu_tanh(bflo(v[c].x)), a1 = gelu_tanh(bfhi(v[c].x)), a2 = gelu_tanh(bflo(v[c].y)), a3 = gelu_tanh(bfhi(v[c].y));
                const float a4 = gelu_tanh(bflo(v[c].z)), a5 = gelu_tanh(bfhi(v[c].z)), a6 = gelu_tanh(bflo(v[c].w)), a7 = gelu_tanh(bfhi(v[c].w));
                s1 += ((a0 + a1) + (a2 + a3)) + ((a4 + a5) + (a6 + a7)); s2 += ((a0 * a0 + a1 * a1) + (a2 * a2 + a3 * a3)) + ((a4 * a4 + a5 * a5) + (a6 * a6 + a7 * a7)); }
        }
        s1 += __shfl_xor(s1, 1); s1 += __shfl_xor(s1, 2); s2 += __shfl_xor(s2, 1); s2 += __shfl_xor(s2, 2);
        const float mean = s1 * (1.f / 768.f), var = fmaxf(s2 * (1.f / 768.f) - mean * mean, 0.f);
        if (qd == 0) { ST[2 * t] = mean; ST[2 * t + 1] = 1.0f / sqrtf(var + EPS); }
    }
    WG_SYNC();
#pragma unroll 1
    for (int g = 0; g < 4; ++g) {
        {
            u32x4 v[6];
#pragma unroll
            for (int i = 0; i < 6; ++i) { const int idx = tid + 512 * i, sr = idx / 24, ch = idx % 24; v[i] = *(const u32x4*)(Zr + (size_t)sr * NZ + ZCV + g * 192 + ch * 8); }
#pragma unroll
            for (int i = 0; i < 6; ++i) { const int idx = tid + 512 * i, sr = idx / 24, ch = idx % 24;
                const float mean = ST[2 * sr], rstd = ST[2 * sr + 1];
                const float* lg = P_sgu_ln_g + l * 768 + g * 192 + ch * 8; const float* lb = P_sgu_ln_b + l * 768 + g * 192 + ch * 8;
                const f32x4 g0 = *(const f32x4*)lg, g1 = *(const f32x4*)(lg + 4), b0 = *(const f32x4*)lb, b1 = *(const f32x4*)(lb + 4);
                u32x4 o;
                o.x = cvt_pk_bf16((gelu_tanh(bflo(v[i].x)) - mean) * rstd * g0.x + b0.x, (gelu_tanh(bfhi(v[i].x)) - mean) * rstd * g0.y + b0.y);
                o.y = cvt_pk_bf16((gelu_tanh(bflo(v[i].y)) - mean) * rstd * g0.z + b0.z, (gelu_tanh(bfhi(v[i].y)) - mean) * rstd * g0.w + b0.w);
                o.z = cvt_pk_bf16((gelu_tanh(bflo(v[i].z)) - mean) * rstd * g1.x + b1.x, (gelu_tanh(bfhi(v[i].z)) - mean) * rstd * g1.y + b1.y);
                o.w = cvt_pk_bf16((gelu_tanh(bflo(v[i].w)) - mean) * rstd * g1.z + b1.z, (gelu_tanh(bfhi(v[i].w)) - mean) * rstd * g1.w + b1.w);
                *(LAS u32x4*)(VN + sr * SG_V_P + ch * 16) = o; }
        }
        WG_SYNC();
        const float* Wg = P_sgu_w + ((size_t)l * 4 + g) * 128 * 128;
#pragma unroll 1
        for (int half = 0; half < 2; ++half) {
            const int tt = half == 0 ? w : 7 - w, nks = (tt >> 1) + 1, t = 16 * tt + fr;
            bf16x8 wf[4];
#pragma unroll
            for (int ks = 0; ks < 4; ++ks) {
                u32x4 pw = (u32x4){0u, 0u, 0u, 0u};
                if (ks < nks) { const float* wp = Wg + (size_t)t * 128 + 32 * ks + 8 * fq; const f32x4 a = *(const f32x4*)wp, c4 = *(const f32x4*)(wp + 4); const int s0 = 32 * ks + 8 * fq;
                    pw.x = cvt_pk_bf16(s0 + 0 <= t ? a.x : 0.f, s0 + 1 <= t ? a.y : 0.f); pw.y = cvt_pk_bf16(s0 + 2 <= t ? a.z : 0.f, s0 + 3 <= t ? a.w : 0.f);
                    pw.z = cvt_pk_bf16(s0 + 4 <= t ? c4.x : 0.f, s0 + 5 <= t ? c4.y : 0.f); pw.w = cvt_pk_bf16(s0 + 6 <= t ? c4.z : 0.f, s0 + 7 <= t ? c4.w : 0.f); }
                wf[ks] = __builtin_bit_cast(bf16x8, pw);
            }
            const float bs = P_sgu_b[((size_t)l * 4 + g) * 128 + t];
            const bf16_t* up = Zr + (size_t)t * NZ + ZCU + g * 192 + 4 * fq;
            bf16_t* op = P_OMIX + (row0 + t) * D + 1280 + g * 192 + 4 * fq;
            u32x2 uv[6];
#pragma unroll
            for (int ci = 0; ci < 6; ++ci) uv[ci] = *(const u32x2*)(up + 16 * (6 * half + ci));
#pragma unroll
            for (int ci = 0; ci < 6; ++ci) {
                const int ct = 6 * half + ci;
                f32x4 a = (f32x4){0.f, 0.f, 0.f, 0.f};
#pragma unroll
                for (int ks = 0; ks < 4; ++ks) if (ks < nks) a = __builtin_amdgcn_mfma_f32_16x16x32_bf16(tr_frag(VN, SG_V_P, 32 * ks, 16 * ct, lane), wf[ks], a, 0, 0, 0);
                u32x2 wv; wv.x = cvt_pk_bf16(gelu_tanh(bflo(uv[ci].x)) * (a[0] + bs), gelu_tanh(bfhi(uv[ci].x)) * (a[1] + bs)); wv.y = cvt_pk_bf16(gelu_tanh(bflo(uv[ci].y)) * (a[2] + bs), gelu_tanh(bfhi(uv[ci].y)) * (a[3] + bs));
                *(u32x2*)(op + 16 * ct) = wv;
            }
        }
        WG_SYNC();
    }
}
__device__ __forceinline__ void attn_combine(Frame& F) {
    const size_t ntask = (size_t)M * 64;
    const float* LSEp = P_LSE; const bf16_t* AOp = P_AO; bf16_t* OMp = P_OMIX;
    for (size_t task = (size_t)F.bid * NT + opq_tid(); task < ntask; task += (size_t)F.G * NT) {
        const size_t row = task >> 6; const int ch = (int)(task & 63), h = ch >> 4;
        const float l0 = LSEp[((size_t)0 * M + row) * 4 + h], l1 = LSEp[((size_t)1 * M + row) * 4 + h], l2 = LSEp[((size_t)2 * M + row) * 4 + h];
        const float mx = fmaxf(l0, fmaxf(l1, l2)); const float e0 = __expf(l0 - mx), e1 = __expf(l1 - mx), e2 = __expf(l2 - mx); const float inv = 1.0f / (e0 + e1 + e2);
        const float w0 = e0 * inv, w1 = e1 * inv, w2 = e2 * inv;
        const u32x4 a = *(const u32x4*)(AOp + ((size_t)0 * M + row) * 512 + ch * 8), bq = *(const u32x4*)(AOp + ((size_t)1 * M + row) * 512 + ch * 8), cq = *(const u32x4*)(AOp + ((size_t)2 * M + row) * 512 + ch * 8);
        u32x4 o;
        o.x = cvt_pk_bf16(w0 * bflo(a.x) + w1 * bflo(bq.x) + w2 * bflo(cq.x), w0 * bfhi(a.x) + w1 * bfhi(bq.x) + w2 * bfhi(cq.x));
        o.y = cvt_pk_bf16(w0 * bflo(a.y) + w1 * bflo(bq.y) + w2 * bflo(cq.y), w0 * bfhi(a.y) + w1 * bfhi(bq.y) + w2 * bfhi(cq.y));
        o.z = cvt_pk_bf16(w0 * bflo(a.z) + w1 * bflo(bq.z) + w2 * bflo(cq.z), w0 * bfhi(a.z) + w1 * bfhi(bq.z) + w2 * bfhi(cq.z));
        o.w = cvt_pk_bf16(w0 * bflo(a.w) + w1 * bflo(bq.w) + w2 * bflo(cq.w), w0 * bfhi(a.w) + w1 * bfhi(bq.w) + w2 * bfhi(cq.w));
        *(u32x4*)(OMp + row * D + ch * 8) = o;
    }
}

constexpr int NPH = 10;
__global__ void __launch_bounds__(NT, 2) mega_fwd(Args args) {
    extern __shared__ __attribute__((aligned(16))) unsigned char lds_raw[];
    Frame F;
    F.lds = (LAS unsigned char*)lds_raw;
    F.G = gridDim.x; F.bid = blockIdx.x;
    unsigned char* ws = args.ws;
    volatile LAS unsigned* MISC = (volatile LAS unsigned*)(F.lds + LDS_MISC);
    if (threadIdx.x < 16) MISC[threadIdx.x] = 0u;
    __syncthreads();
    unsigned* ctl = (unsigned*)(ws + WS_CTL);
    const bool single = (args.ph_hi - args.ph_lo) > 1 || (args.l_hi - args.l_lo) > 1;
    XcdBarrier bar; bar.bar = ctl + CW_BAR; bar.x = 0; bar.st = nullptr;
    if (single) bar = xcd_barrier_post(ctl + CW_BAR, MISC);
#ifndef REP_MIX
#define REP_MIX 1
#endif
#ifndef REP_G1
#define REP_G1 1
#endif
#ifndef REP_THIN
#define REP_THIN 1
#endif
#ifndef REP_ATT
#define REP_ATT 1
#endif
#ifndef REP_GLA1
#define REP_GLA1 1
#endif
#ifndef REP_SGU
#define REP_SGU 1
#endif
#ifndef REP_SCAN
#define REP_SCAN 1
#endif
#ifndef REP_G3
#define REP_G3 1
#endif
#ifndef REP_CMB
#define REP_CMB 1
#endif
#ifndef REP_P5
#define REP_P5 1
#endif
#ifndef REP_P8
#define REP_P8 1
#endif
#ifndef PH_MASK
#define PH_MASK 0x3ff
#endif
#define IN(k) (((PH_MASK >> (k)) & 1) && args.ph_lo <= (k) && (k) < args.ph_hi)
#define GRID_BAR() do { if (single) xcd_barrier(bar); } while (0)

    for (int l = args.l_lo; l < args.l_hi; ++l) {
        for (int rp = 0; rp < REP_THIN; ++rp)
        if (IN(0)) { p0_convert(F, l); if (l == 0) cast_rows(F, P_x, P_XN, P_RS1, P_XB8); GRID_BAR(); }
        for (int rp = 0; rp < REP_G1; ++rp)
        if (IN(1)) {
            {
                pg8::Gemm g{P_XB8, P_W8, M, N8, D, D, D}; pg8::StaticOrder S; S.init(M, N8, F.G, F.bid); S.wgm = 8;
                if (F.G == 256) { S.full = 20; S.c0 = 128; S.extra = 2; }
                pg8::EpiStoreBf16 E{P_Z, NZ, P_RS1 + (size_t)l * M, 18, 0, ZGA, W8_INV};
                pg8::gemm_phase<pg8::EpiStoreBf16, true, true>(F.lds, g, S, E);
            }
            {
                pg8::Gemm g{P_XN, P_WIN, M, NB, D, D, D}; pg8::StaticOrder S; S.init(M, NB, F.G, F.bid); S.wgm = 8;
                pg8::EpiStoreBf16 E{P_Z, NZ, P_RS1 + (size_t)l * M, 12, ZBQ, ZGL, 1.0f};
                pg8::gemm_phase<pg8::EpiStoreBf16, true, false>(F.lds, g, S, E);
            }
            GRID_BAR();
        }
        for (int rp = 0; rp < REP_MIX; ++rp) {
        if (IN(2)) {
            for (int q = 0; q < REP_ATT; ++q) for (int u = F.bid; u < 768; u += F.G) attn_seg(F, u, l);
            for (int q = 0; q < REP_GLA1; ++q) for (int u = F.bid; u < 2048; u += F.G) gla1_unit(F, u, l);
            for (int q = 0; q < REP_SGU; ++q) for (int u = F.bid; u < 256; u += F.G) sgu_unit(F, u, l);
            GRID_BAR();
        }
        if (IN(3)) { for (int q = 0; q < REP_SCAN; ++q) gla_scan(F); GRID_BAR(); }
        if (IN(4)) {
            for (int q = 0; q < REP_G3; ++q) for (int u = F.bid; u < 1024; u += F.G) gla3_unit(F, u, l);
            for (int q = 0; q < REP_CMB; ++q) attn_combine(F);
            GRID_BAR();
        }
        }
        for (int rp = 0; rp < REP_P5; ++rp)
        if (IN(5)) {
            {
                pg8::Gemm g{P_OMIX, P_WBR, M, D, D, D, D}; pg8::StaticOrder S; S.init(M, D, F.G, F.bid); S.nbr = 3;
                pg8::EpiGate E{P_Y, P_Z + ZGA, D, NZ};
                pg8::gemm_phase<pg8::EpiGate, true, false, true>(F.lds, g, S, E);
            }
            GRID_BAR();
        }
        if (IN(6)) {
            pg8::Gemm g{P_Y, P_WO, M, D, D, D, D}; pg8::StaticOrder S; S.init(M, D, F.G, F.bid);
            pg8::EpiRes E{P_XN, (float*)nullptr, D, P_RS2 + (size_t)l * M, (unsigned char*)nullptr};
            pg8::gemm_phase<pg8::EpiRes, true>(F.lds, g, S, E);
            GRID_BAR();
        }
        for (int rp = 0; rp < REP_THIN; ++rp)
        if (IN(7)) { }
        for (int rp = 0; rp < REP_P8; ++rp)
        if (IN(8)) {
            pg8::Gemm g{P_XN, P_WFI, M, NFI, D, D, D}; pg8::StaticOrder S; S.init(M, NFI, F.G, F.bid); S.wgm = 8;
            pg8::EpiSwiGLU E{P_H, DFF, P_RS2 + (size_t)l * M};
            pg8::gemm_phase<pg8::EpiSwiGLU, true>(F.lds, g, S, E);
            GRID_BAR();
        }
        if (IN(9)) {
            pg8::Gemm g{P_H, P_WFO, M, D, DFF, DFF, DFF}; pg8::StaticOrder S; S.init(M, D, F.G, F.bid);
            pg8::EpiRes E{P_XN, (l + 1 < DEPTH) ? (float*)nullptr : P_out, D, P_RS1 + (size_t)(l + 1 < DEPTH ? l + 1 : 0) * M, (l + 1 < DEPTH) ? P_XB8 : (unsigned char*)nullptr};
            pg8::gemm_phase<pg8::EpiRes, true>(F.lds, g, S, E);
            GRID_BAR();
        }
    }
#undef IN
#undef GRID_BAR
}

extern "C" void kernel_launch(void* const* d_in, const int* in_sizes, int n_in, void* d_out, int out_size, void* d_ws, size_t ws_size, hipStream_t stream) {
    static int grid = 0;
    if (grid == 0) {
        if (n_in != 18 || out_size != M * D || ws_size < WS_END) { fprintf(stderr, "kernel_launch: unexpected shapes (n_in %d, out %d, ws %zu < %zu)\n", n_in, out_size, ws_size, (size_t)WS_END); grid = -1; return; }
        int dev = 0, cus = 0, per_cu = 0;
        if (hipGetDevice(&dev) != hipSuccess || hipDeviceGetAttribute(&cus, hipDeviceAttributeMultiprocessorCount, dev) != hipSuccess) { grid = -1; return; }
        if (hipFuncSetAttribute((const void*)mega_fwd, hipFuncAttributeMaxDynamicSharedMemorySize, LDS_BYTES) != hipSuccess) { fprintf(stderr, "kernel_launch: hipFuncSetAttribute failed\n"); grid = -1; return; }
        if (hipOccupancyMaxActiveBlocksPerMultiprocessor(&per_cu, (const void*)mega_fwd, NT, LDS_BYTES) != hipSuccess || per_cu < 1) { fprintf(stderr, "kernel_launch: occupancy query says %d\n", per_cu); }
        (void)hipGetLastError();
        grid = cus;
    }
    if (grid < 0) return;
    (void)hipMemsetAsync((char*)d_ws + WS_CTL, 0, CTL_ZERO_BYTES, stream);
    Args a{};
    for (int i = 0; i < 18; ++i) a.in[i] = (const float*)d_in[i];
    a.out = (float*)d_out; a.ws = (unsigned char*)d_ws;
#if MK_MULTI
    for (int l = 0; l < DEPTH; ++l)
        for (int p = 0; p < NPH; ++p) { a.l_lo = l; a.l_hi = l + 1; a.ph_lo = p; a.ph_hi = p + 1; hipLaunchKernelGGL(mega_fwd, dim3(grid), dim3(NT), LDS_BYTES, stream, a); }
#else
    a.l_lo = 0; a.l_hi = DEPTH; a.ph_lo = 0; a.ph_hi = NPH;
    hipLaunchKernelGGL(mega_fwd, dim3(grid), dim3(NT), LDS_BYTES, stream, a);
#endif
}
```

```cpp
#include <hip/hip_runtime.h>
#include <cstdio>
#include <cstdint>

#ifndef MK_MULTI
#define MK_MULTI 0
#endif

#define LAS __attribute__((address_space(3)))
#define GAS __attribute__((address_space(1)))
typedef unsigned short bf16_t;
typedef short bf16x8 __attribute__((ext_vector_type(8)));
typedef short s16x4 __attribute__((ext_vector_type(4)));
typedef float f32x4 __attribute__((ext_vector_type(4)));
typedef float f32x2 __attribute__((ext_vector_type(2)));
typedef unsigned u32x4 __attribute__((ext_vector_type(4)));
typedef unsigned u32x2 __attribute__((ext_vector_type(2)));

constexpr int D = 2048, BATCH = 8, SEQ = 4096, DEPTH = 4, M = BATCH * SEQ;
constexpr int NZ = 14080;
constexpr int ZQ = 0, ZK = 1536, ZV = 3072, ZBQ = 4608, ZBK = 4992, ZBV = 5376, ZCU = 6144, ZCV = 6912, ZGA = 7680, ZGB = 9728, ZGC = 11776, ZGL = 13824;
constexpr int DIN = 13840, DFF = 5632, NFI = 2 * DFF;
constexpr int GLA_DK = 96, GLA_DV = 192, NCHK = SEQ / 64;
constexpr float EPS = 1e-6f;
constexpr int NT = 512, NWAVES = 8;

constexpr size_t al256(size_t x) { return (x + 255) & ~(size_t)255; }
constexpr size_t WS_CTL = 0, CTL_ZERO_BYTES = 4u << 20;
typedef unsigned long long rs_t;
constexpr float RS_SCALE = 16777216.0f, RS_INV = 1.0f / 16777216.0f;
constexpr size_t WS_RS1 = 256u << 10;
constexpr size_t WS_RS2 = WS_RS1 + (size_t)DEPTH * M * 8;
static_assert(WS_RS2 + (size_t)DEPTH * M * 8 <= CTL_ZERO_BYTES, "RS buffers inside the zeroed region");
constexpr int N8 = 10752, NB = 3328;
constexpr float W8_SCALE = 256.0f, W8_INV = 1.0f / 256.0f;
constexpr size_t WS_WIN = CTL_ZERO_BYTES;
constexpr size_t WS_W8 = WS_WIN + (size_t)NB * D * 2;
constexpr size_t WS_XB8 = WS_W8 + (size_t)N8 * D;
constexpr size_t WS_WBR = WS_XB8 + (size_t)M * D;
constexpr size_t WS_WO = WS_WBR + (size_t)D * D * 2;
constexpr size_t WS_WFI = WS_WO + (size_t)D * D * 2;
constexpr size_t WS_WFO = WS_WFI + (size_t)NFI * D * 2;
constexpr size_t WS_XN = WS_WFO + (size_t)D * DFF * 2;
constexpr size_t WS_Y = WS_XN + (size_t)M * D * 2;
constexpr size_t WS_OMIX = WS_Y + (size_t)M * D * 2;
constexpr size_t WS_Z = WS_OMIX + (size_t)M * D * 2;
constexpr size_t WS_SP = WS_Z + (size_t)M * NZ * 2;
constexpr size_t WS_QT = WS_SP + (size_t)BATCH * NCHK * 4 * GLA_DV * GLA_DK * 2;
constexpr size_t WS_KT = WS_QT + (size_t)M * 384 * 2;
constexpr size_t WS_DL = WS_KT + (size_t)M * 384 * 2;
constexpr size_t WS_LSE = WS_DL + (size_t)BATCH * NCHK * 4 * GLA_DK * 4;
constexpr size_t WS_END = WS_LSE + (size_t)3 * M * 4 * 4;
constexpr size_t OUT_SL = 0;
constexpr size_t OUT_AO = OUT_SL + (size_t)BATCH * NCHK * 4 * GLA_DV * GLA_DK * 2;
static_assert(OUT_AO + (size_t)3 * M * 512 * 2 <= (size_t)M * D * 4, "scratch fits in d_out");
constexpr int CW_BAR = 4096;

typedef __bf16 bf16x2_t __attribute__((ext_vector_type(2)));
__device__ __forceinline__ unsigned cvt_pk_bf16(float lo, float hi) { const f32x2 v = {lo, hi}; return __builtin_bit_cast(unsigned, __builtin_convertvector(v, bf16x2_t)); }
__device__ __forceinline__ float bflo(unsigned w) { return __uint_as_float(w << 16); }
__device__ __forceinline__ float bfhi(unsigned w) { return __uint_as_float(w & 0xffff0000u); }
__device__ __forceinline__ float fast_rcp(float x) { return __builtin_amdgcn_rcpf(x); }
__device__ __forceinline__ float sigmoidf_(float x) { return fast_rcp(1.0f + __expf(-x)); }
__device__ __forceinline__ float gelu_tanh(float x) { const float u = 0.7978845608028654f * (x + 0.044715f * x * x * x); return x * fast_rcp(1.0f + __expf(-2.0f * u)); }
__device__ __forceinline__ float wave_sum(float v) {
#pragma unroll
    for (int o = 1; o < 64; o <<= 1) v += __shfl_xor(v, o);
    return v;
}
__device__ __forceinline__ int opq_tid() { int t = threadIdx.x; asm volatile("" : "+v"(t)); return t; }
#define LDS_WAIT() asm volatile("s_waitcnt lgkmcnt(0)" ::: "memory")
#define WG_SYNC() asm volatile("s_waitcnt lgkmcnt(0)\n\ts_barrier" ::: "memory")
#define VM_WAIT() asm volatile("s_waitcnt vmcnt(0)" ::: "memory")

namespace pg8 {
constexpr int BM = 256, BK = 64, HALF = 128, HTB = HALF * BK * 2, STAGE_BYTES = 8 * HTB, NXCD = 8;
typedef int v4i_t __attribute__((ext_vector_type(4)));
typedef int v8i_t __attribute__((ext_vector_type(8)));
__host__ __device__ __forceinline__ int lds_byte(int r, int c) { const int st = (r >> 4) * 2 + (c >> 5), rr = r & 15, cc = c & 31, ob = rr * 64 + cc * 2; return st * 1024 + (ob ^ (((ob >> 9) & 1) << 5)); }
__host__ __device__ __forceinline__ void stage_rc(int b, int& R, int& C) { const int st = b / 1024, sb = b % 1024, swz = sb ^ (((sb >> 9) & 1) << 5); R = (st >> 1) * 16 + swz / 64; C = (st & 1) * 32 + (swz % 64) / 2; }
__host__ __device__ __forceinline__ void stage_rc8(int b, int& R, int& Cb) { const int rb = b >> 11, within = b & 2047, slot = within >> 5, half = (within >> 4) & 1, fq = slot >> 4, fr = slot & 15, k = half ^ (fq & 1); R = 16 * rb + fr; Cb = 64 * k + 16 * fq; }
__host__ __device__ __forceinline__ int perm32(int rho) { const int n = rho >> 4, i = rho & 15; return 8 * (i >> 2) + 4 * n + (i & 3); }
struct Unit { int pm, pn, br; };
struct Gemm { const void* A; const void* Bt; int M, N, K, lda, ldb; };
struct StaticOrder {
    int nM, nN, nwg, G, c, full, c0, extra, nbr, wgm;
    __host__ __device__ void init(int M_, int N_, int G_, int c_) { nM = M_ / BM; nN = N_ / BM; nwg = nM * nN; G = G_; c = c_; full = 0x3fffffff; c0 = 0; extra = 0; nbr = 1; wgm = 4; }
    __host__ __device__ bool next(int i, Unit& u) const {
        long L; u.br = 0;
        if (nbr > 1) { u.br = i % nbr; i /= nbr; }
        if (i < full) L = (long)i * G + c; else { const int j = i - full; if (c < c0 || j >= extra) return false; L = (long)full * G + (long)(c - c0) * extra + j; }
        if (L >= nwg) return false;
        int wgid = (int)L; const int xcd = wgid % NXCD; { const int q = nwg / NXCD, r = nwg % NXCD, off = wgid / NXCD; wgid = (xcd < r ? xcd * (q + 1) : r * (q + 1) + (xcd - r) * q) + off; }
        const int nig = wgm * nN, gid = wgid / nig, fm = gid * wgm, gsz = (nM - fm) < wgm ? (nM - fm) : wgm;
        u.pm = fm + ((wgid % nig) % gsz); u.pn = ((wgid % nig) / gsz + ((nwg % (NXCD * nig)) == 0 ? xcd * (nN / NXCD) : 0)) % nN; return true;
    }
};
struct EpiStoreBf16 {
    static constexpr bool PERM = true, ROWSCALE = true, SWAP = true;
    bf16_t* O; int ldc; const rs_t* rs; int split, off_lo, off_hi; float mul;
    __device__ __forceinline__ void operator()(const f32x4 (&acc)[2][2][4][2], const Unit& u, int wr, int wc, int fr, int fq, const LAS float* rsl) const {
        const int row0 = u.pm * BM + wr * 64 + 4 * fq, col0 = (u.pn < split ? off_lo + u.pn * BM : off_hi + (u.pn - split) * BM) + wc * 64 + 4 * fr;
#pragma unroll
        for (int ai = 0; ai < 2; ++ai)
#pragma unroll
            for (int m = 0; m < 4; ++m) { bf16_t* rowp = O + (size_t)(row0 + ai * HALF + m * 16) * ldc + col0;
                const f32x4 sc = *(const LAS f32x4*)(rsl + wr * 64 + 4 * fq + ai * HALF + m * 16) * mul;
#pragma unroll
                for (int i = 0; i < 4; ++i) { u32x2 w; w.x = cvt_pk_bf16(acc[ai][0][m][0][i] * sc[i], acc[ai][0][m][1][i] * sc[i]); w.y = cvt_pk_bf16(acc[ai][1][m][0][i] * sc[i], acc[ai][1][m][1][i] * sc[i]);
                    __builtin_nontemporal_store(w, (u32x2*)(rowp + (size_t)i * ldc)); } }
    }
};
struct EpiGate {
    static constexpr bool PERM = true, ROWSCALE = false, SWAP = false;
    bf16_t* Y; const bf16_t* G; int ldy, ldg;
    static __device__ __forceinline__ float e_neg(float g) { return __expf(-__builtin_amdgcn_fmed3f(g, -30.0f, 30.0f)); }
    __device__ __forceinline__ void operator()(f32x4 (&acc)[2][2][4][2], const Unit& u, int wr, int wc, int fr, int fq, const LAS float*) const {
        const int row0 = u.pm * BM + wr * 64 + fr, col0 = u.pn * BM + wc * 32 + 8 * fq; const bf16_t* Gb = G + u.br * D;
        if (u.br < 2) {
#pragma unroll
            for (int ai = 0; ai < 2; ++ai) {
                u32x4 g0[4][2], g1[4][2];
#pragma unroll
                for (int m = 0; m < 4; ++m) { const size_t row = (size_t)(row0 + ai * HALF + m * 16);
#pragma unroll
                    for (int bj = 0; bj < 2; ++bj) { g0[m][bj] = *(const u32x4*)(Gb + row * ldg + col0 + bj * HALF); g1[m][bj] = *(const u32x4*)(Gb + D + row * ldg + col0 + bj * HALF); } }
#pragma unroll
                for (int m = 0; m < 4; ++m)
#pragma unroll
                    for (int bj = 0; bj < 2; ++bj) { const u32x4 a = g0[m][bj], b = g1[m][bj];
                        const unsigned aw[4] = {a.x, a.y, a.z, a.w}, bw[4] = {b.x, b.y, b.z, b.w};
#pragma unroll
                        for (int q = 0; q < 4; ++q) {
                            const float rl = (1.0f + e_neg(bflo(bw[q]))) * fast_rcp(1.0f + e_neg(bflo(aw[q]))), rh = (1.0f + e_neg(bfhi(bw[q]))) * fast_rcp(1.0f + e_neg(bfhi(aw[q])));
                            acc[ai][bj][m][q >> 1][2 * (q & 1)] *= rl; acc[ai][bj][m][q >> 1][2 * (q & 1) + 1] *= rh; } }
                asm volatile("" ::: "memory"); }
        } else {
#pragma unroll
            for (int ai = 0; ai < 2; ++ai) {
                u32x4 g[4][2];
#pragma unroll
                for (int m = 0; m < 4; ++m) { const size_t row = (size_t)(row0 + ai * HALF + m * 16);
#pragma unroll
                    for (int bj = 0; bj < 2; ++bj) g[m][bj] = *(const u32x4*)(Gb + row * ldg + col0 + bj * HALF); }
#pragma unroll
                for (int m = 0; m < 4; ++m) { const size_t row = (size_t)(row0 + ai * HALF + m * 16);
#pragma unroll
                    for (int bj = 0; bj < 2; ++bj) { const f32x4 v0 = acc[ai][bj][m][0], v1 = acc[ai][bj][m][1]; const u32x4 gg = g[m][bj];
                        float o[8];
                        o[0] = v0[0] * fast_rcp(1.0f + e_neg(bflo(gg.x))); o[1] = v0[1] * fast_rcp(1.0f + e_neg(bfhi(gg.x)));
                        o[2] = v0[2] * fast_rcp(1.0f + e_neg(bflo(gg.y))); o[3] = v0[3] * fast_rcp(1.0f + e_neg(bfhi(gg.y)));
                        o[4] = v1[0] * fast_rcp(1.0f + e_neg(bflo(gg.z))); o[5] = v1[1] * fast_rcp(1.0f + e_neg(bfhi(gg.z)));
                        o[6] = v1[2] * fast_rcp(1.0f + e_neg(bflo(gg.w))); o[7] = v1[3] * fast_rcp(1.0f + e_neg(bfhi(gg.w)));
                        u32x4 w; w.x = cvt_pk_bf16(o[0], o[1]); w.y = cvt_pk_bf16(o[2], o[3]); w.z = cvt_pk_bf16(o[4], o[5]); w.w = cvt_pk_bf16(o[6], o[7]);
                        *(u32x4*)(Y + row * ldy + col0 + bj * HALF) = w; } }
                asm volatile("" ::: "memory"); }
        }
    }
};
struct EpiRes {
    static constexpr bool PERM = true, ROWSCALE = false, SWAP = false;
    bf16_t* xb; float* outf; int ldc; rs_t* rs; unsigned char* xb8;
    __device__ __forceinline__ void operator()(const f32x4 (&acc)[2][2][4][2], const Unit& u, int wr, int wc, int fr, int fq, const LAS float*) const {
        const int row0 = u.pm * BM + wr * 64 + fr, col0 = u.pn * BM + wc * 32 + 8 * fq;
#pragma unroll
        for (int ai = 0; ai < 2; ++ai) {
            u32x4 bs[4][2];
#pragma unroll
            for (int m = 0; m < 4; ++m) { const size_t off = (size_t)(row0 + ai * HALF + m * 16) * ldc + col0;
#pragma unroll
                for (int bj = 0; bj < 2; ++bj) bs[m][bj] = *(const u32x4*)(xb + off + bj * HALF); }
#pragma unroll
            for (int m = 0; m < 4; ++m) { const size_t off = (size_t)(row0 + ai * HALF + m * 16) * ldc + col0; float ss = 0.f;
#pragma unroll
                for (int bj = 0; bj < 2; ++bj) { const u32x4 b4 = bs[m][bj];
                    const f32x4 o0 = (f32x4){bflo(b4.x), bfhi(b4.x), bflo(b4.y), bfhi(b4.y)} + acc[ai][bj][m][0], o1 = (f32x4){bflo(b4.z), bfhi(b4.z), bflo(b4.w), bfhi(b4.w)} + acc[ai][bj][m][1];
                    if (outf) { *(f32x4*)(outf + off + bj * HALF) = o0; *(f32x4*)(outf + off + bj * HALF + 4) = o1; }
                    else { u32x4 w; w.x = cvt_pk_bf16(o0[0], o0[1]); w.y = cvt_pk_bf16(o0[2], o0[3]); w.z = cvt_pk_bf16(o1[0], o1[1]); w.w = cvt_pk_bf16(o1[2], o1[3]); *(u32x4*)(xb + off + bj * HALF) = w;
                        ss += ((o0[0] * o0[0] + o0[1] * o0[1]) + (o0[2] * o0[2] + o0[3] * o0[3])) + ((o1[0] * o1[0] + o1[1] * o1[1]) + (o1[2] * o1[2] + o1[3] * o1[3])); }
                    if (xb8) { u32x2 q; q.x = 0u; q.y = 0u; q.x = __builtin_amdgcn_cvt_pk_fp8_f32(o0[0], o0[1], q.x, false); q.x = __builtin_amdgcn_cvt_pk_fp8_f32(o0[2], o0[3], q.x, true);
                        q.y = __builtin_amdgcn_cvt_pk_fp8_f32(o1[0], o1[1], q.y, false); q.y = __builtin_amdgcn_cvt_pk_fp8_f32(o1[2], o1[3], q.y, true); *(u32x2*)(xb8 + off + bj * HALF) = q; } }
                if (!outf) { ss += __shfl_xor(ss, 16); ss += __shfl_xor(ss, 32); if (fq == 0) __hip_atomic_fetch_add(rs + row0 + ai * HALF + m * 16, (rs_t)(ss * RS_SCALE + 0.5f), __ATOMIC_RELAXED, __HIP_MEMORY_SCOPE_AGENT); } }
            asm volatile("" ::: "memory"); }
    }
};
struct EpiSwiGLU {
    static constexpr bool PERM = true, ROWSCALE = true, SWAP = false;
    bf16_t* H; int ldh; const rs_t* rs;
    __device__ __forceinline__ void operator()(const f32x4 (&acc)[2][2][4][2], const Unit& u, int wr, int wc, int fr, int fq, const LAS float* rsl) const {
        const int row0 = u.pm * BM + wr * 64 + fr, col0 = u.pn * HALF + wc * 32 + 8 * fq;
#pragma unroll
        for (int ai = 0; ai < 2; ++ai)
#pragma unroll
            for (int m = 0; m < 4; ++m) { const float sc = rsl[wr * 64 + fr + ai * HALF + m * 16];
                const f32x4 g0 = acc[ai][0][m][0] * sc, g1 = acc[ai][0][m][1] * sc, u0 = acc[ai][1][m][0] * sc, u1 = acc[ai][1][m][1] * sc;
                float o[8];
#pragma unroll
                for (int j = 0; j < 4; ++j) { o[j] = g0[j] * sigmoidf_(g0[j]) * u0[j]; o[4 + j] = g1[j] * sigmoidf_(g1[j]) * u1[j]; }
                u32x4 w; w.x = cvt_pk_bf16(o[0], o[1]); w.y = cvt_pk_bf16(o[2], o[3]); w.z = cvt_pk_bf16(o[4], o[5]); w.w = cvt_pk_bf16(o[6], o[7]);
                __builtin_nontemporal_store(w, (u32x4*)(H + (size_t)(row0 + ai * HALF + m * 16) * ldh + col0)); }
    }
};

template <class Epi, bool ALIGN_EPI, bool FP8 = false, bool BR3 = false>
__device__ __forceinline__ void gemm_phase(LAS unsigned char* lds, const Gemm g, const StaticOrder& S, const Epi& E) {
    const int tid = opq_tid(), wid = __builtin_amdgcn_readfirstlane(tid >> 6), lane = tid & 63, wr = wid >> 2, wc = wid & 3, fr = lane & 15, fq = lane >> 4;
    constexpr int ESZ = FP8 ? 1 : 2;
    const int K = g.K; int nt = K * ESZ / (BK * 2);
#define PG8_KOFF(u) (BR3 ? ((u).br == 0 ? 0 : ((u).br == 1 ? 1024 : 2560)) : 0)
#define PG8_NT(u) (BR3 ? ((u).br == 0 ? 8 : 12) : nt)
    unsigned voffA[2], voffB[2];
#pragma unroll
    for (int i = 0; i < 2; ++i) { int R, C; if constexpr (FP8) stage_rc8(tid * 16 + i * 8192, R, C); else { stage_rc(tid * 16 + i * 8192, R, C); C *= 2; }
        const int Rb = Epi::SWAP ? (64 * (R >> 5) + 4 * (R & 15) + ((R >> 4) & 1)) : (Epi::PERM ? ((R & ~31) + perm32(R & 31)) : R);
        voffA[i] = (unsigned)(R * g.lda * ESZ + C); voffB[i] = (unsigned)(Rb * g.ldb * ESZ + C); }
    const size_t kstep = (size_t)(BK * 2);
    const size_t hstepA = (size_t)HALF * g.lda * ESZ, hstepB = (size_t)(Epi::SWAP ? 2 : HALF) * g.ldb * ESZ;
    const size_t tstepA = 2 * hstepA, tstepB = (size_t)BM * g.ldb * ESZ;
    const unsigned ldsw = (unsigned)wid * 1024u;
    const int aoff = FP8 ? wr * 8192 + lane * 32 : lds_byte(wr * 64 + fr, fq * 8), boff = FP8 ? wc * 4096 + lane * 32 : lds_byte(wc * 32 + fr, fq * 8);
    LAS float* rsl = (LAS float*)(lds + STAGE_BYTES);
#define PG8_SA(b, h) (((b) * 2 + (h)) * HTB)
#define PG8_SB(b, h) ((4 + (b) * 2 + (h)) * HTB)
#define PG8_STAGE(bufoff, gbase, voff) do { _Pragma("unroll") for (int _i = 0; _i < 2; ++_i) \
        __builtin_amdgcn_global_load_lds((const unsigned*)((const char*)(gbase) + (voff)[_i]), (LAS unsigned*)(lds + (bufoff) + ldsw + _i * 8192), 16, 0, 0); } while (0)
#define PG8_LDA(dst, b, h) do { _Pragma("unroll") for (int m = 0; m < 4; ++m) { if constexpr (FP8) { const v4i_t lo_ = *(const LAS v4i_t*)(lds + PG8_SA(b, h) + aoff + m * 2048), hi_ = *(const LAS v4i_t*)(lds + PG8_SA(b, h) + aoff + m * 2048 + 16); dst##8[m] = __builtin_shufflevector(lo_, hi_, 0, 1, 2, 3, 4, 5, 6, 7); } \
        else { _Pragma("unroll") for (int k = 0; k < 2; ++k) dst[m][k] = *(const LAS bf16x8*)(lds + PG8_SA(b, h) + aoff + m * 2048 + k * 1024); } } } while (0)
#define PG8_LDB(dst, b, h) do { _Pragma("unroll") for (int n = 0; n < 2; ++n) { if constexpr (FP8) { const v4i_t lo_ = *(const LAS v4i_t*)(lds + PG8_SB(b, h) + boff + n * 2048), hi_ = *(const LAS v4i_t*)(lds + PG8_SB(b, h) + boff + n * 2048 + 16); dst##8[n] = __builtin_shufflevector(lo_, hi_, 0, 1, 2, 3, 4, 5, 6, 7); } \
        else { _Pragma("unroll") for (int k = 0; k < 2; ++k) dst[n][k] = *(const LAS bf16x8*)(lds + PG8_SB(b, h) + boff + n * 2048 + k * 1024); } } } while (0)
#define PG8_MMA(ai, bj, At, Bt) do { __builtin_amdgcn_s_setprio(1); _Pragma("unroll") for (int m = 0; m < 4; ++m) _Pragma("unroll") for (int n = 0; n < 2; ++n) { \
        if constexpr (FP8) { if constexpr (Epi::SWAP) asm volatile("v_mfma_f32_16x16x128_f8f6f4 %0, %1, %2, %0" : "+v"(acc[ai][bj][m][n]) : "v"(At##8[m]), "v"(Bt##8[n])); \
            else asm volatile("v_mfma_f32_16x16x128_f8f6f4 %0, %1, %2, %0" : "+v"(acc[ai][bj][m][n]) : "v"(Bt##8[n]), "v"(At##8[m])); }   \
        else { _Pragma("unroll") for (int k = 0; k < 2; ++k) acc[ai][bj][m][n] = Epi::SWAP ? __builtin_amdgcn_mfma_f32_16x16x32_bf16(At[m][k], Bt[n][k], acc[ai][bj][m][n], 0, 0, 0) : __builtin_amdgcn_mfma_f32_16x16x32_bf16(Bt[n][k], At[m][k], acc[ai][bj][m][n], 0, 0, 0); } } __builtin_amdgcn_s_setprio(0); } while (0)
#define PG8_WAIT_V(n) asm volatile("s_waitcnt vmcnt(" #n ")" ::: "memory")
#define PG8_WAIT_L(n) asm volatile("s_waitcnt lgkmcnt(" #n ")" ::: "memory")
#define PG8_BAR __builtin_amdgcn_s_barrier()
#define PG8_SCHED __builtin_amdgcn_sched_barrier(0)
    Unit cur, nxt; int ui = 0;
    if (!S.next(0, cur)) return;
    f32x4 acc[2][2][4][2];
#pragma unroll
    for (int a = 0; a < 2; ++a)
#pragma unroll
        for (int b = 0; b < 2; ++b)
#pragma unroll
            for (int m = 0; m < 4; ++m)
#pragma unroll
                for (int n = 0; n < 2; ++n) acc[a][b][m][n] = (f32x4){0.f, 0.f, 0.f, 0.f};
    bf16x8 At[4][2], B0[2][2], B1[2][2];
    v8i_t At8[4], B08[2], B18[2];
    const char* cA = (const char*)g.A + (size_t)cur.pm * tstepA + PG8_KOFF(cur); const char* cB = (const char*)g.Bt + (size_t)cur.pn * tstepB + PG8_KOFF(cur);
    PG8_STAGE(PG8_SB(0, 0), cB, voffB); PG8_STAGE(PG8_SB(0, 1), cB + hstepB, voffB); PG8_STAGE(PG8_SA(0, 0), cA, voffA); PG8_STAGE(PG8_SA(0, 1), cA + hstepA, voffA);
    if (wr == 1) PG8_BAR;
    PG8_WAIT_V(2); PG8_BAR;
    PG8_STAGE(PG8_SB(1, 0), cB + kstep, voffB); PG8_STAGE(PG8_SA(1, 0), cA + kstep, voffA); PG8_STAGE(PG8_SB(1, 1), cB + hstepB + kstep, voffB);
    PG8_WAIT_V(6); PG8_BAR;
    for (;;) {
        const bool has_next = S.next(ui + 1, nxt);
        rs_t rv = 0; if constexpr (Epi::ROWSCALE) { const rs_t* rp = E.rs + cur.pm * BM + (tid & 255); asm volatile("global_load_dwordx2 %0, %1, off" : "=v"(rv) : "v"(rp) : "memory"); }
        const char* nA = has_next ? (const char*)g.A + (size_t)nxt.pm * tstepA + PG8_KOFF(nxt) : cA; const char* nB = has_next ? (const char*)g.Bt + (size_t)nxt.pn * tstepB + PG8_KOFF(nxt) : cB;
        nt = PG8_NT(cur);
        for (int t = 0; t < nt; t += 2) {
            const bool last = (t == nt - 2);
            const char* a1 = cA + (size_t)(t + 1) * kstep;
            const char* a2 = last ? nA : cA + (size_t)(t + 2) * kstep; const char* b2 = last ? nB : cB + (size_t)(t + 2) * kstep;
            const char* a3 = a2 + kstep; const char* b3 = b2 + kstep;
            PG8_LDB(B0, 0, 0); PG8_LDB(B1, 0, 1); PG8_SCHED; PG8_LDA(At, 0, 0); PG8_STAGE(PG8_SA(1, 1), a1 + hstepA, voffA);
            PG8_WAIT_V(8); PG8_WAIT_L(0); PG8_BAR; PG8_MMA(0, 0, At, B0); PG8_MMA(0, 1, At, B1); PG8_BAR; PG8_SCHED;
            PG8_LDA(At, 0, 1); PG8_STAGE(PG8_SB(0, 0), b2, voffB); PG8_STAGE(PG8_SB(0, 1), b2 + hstepB, voffB); PG8_STAGE(PG8_SA(0, 0), a2, voffA);
            PG8_WAIT_V(8); PG8_WAIT_L(0); PG8_BAR; PG8_MMA(1, 0, At, B0); PG8_MMA(1, 1, At, B1); PG8_BAR; PG8_SCHED;
            PG8_LDB(B0, 1, 0); PG8_LDB(B1, 1, 1); PG8_SCHED; PG8_LDA(At, 1, 0); PG8_STAGE(PG8_SA(0, 1), a2 + hstepA, voffA);
            PG8_WAIT_V(8); PG8_WAIT_L(0); PG8_BAR; PG8_MMA(0, 0, At, B0); PG8_MMA(0, 1, At, B1); PG8_BAR; PG8_SCHED;
            PG8_LDA(At, 1, 1); PG8_STAGE(PG8_SB(1, 0), b3, voffB); PG8_STAGE(PG8_SB(1, 1), b3 + hstepB, voffB); PG8_STAGE(PG8_SA(1, 0), a3, voffA);
            PG8_WAIT_V(8); PG8_WAIT_L(0); PG8_BAR; PG8_MMA(1, 0, At, B0); PG8_MMA(1, 1, At, B1); PG8_BAR; PG8_SCHED;
        }
        if constexpr (FP8) asm volatile("s_nop 7\n\ts_nop 7\n\ts_nop 7" ::: "memory");
        if constexpr (ALIGN_EPI) { if (wr == 0) PG8_BAR; }
        if constexpr (Epi::ROWSCALE) {
            static_assert(ALIGN_EPI, "row-scale table needs the aligned epilogue");
            asm volatile("s_waitcnt vmcnt(0)" : "+v"(rv) :: "memory");
            if (tid < 256) rsl[tid] = 1.0f / sqrtf((float)rv * (RS_INV / D) + EPS);
            PG8_WAIT_L(0); PG8_BAR; }
        E(acc, cur, wr, wc, fr, fq, rsl);
        if (!has_next) break;
        if (!BR3 || cur.br == 2) {
#pragma unroll
        for (int a = 0; a < 2; ++a)
#pragma unroll
            for (int b = 0; b < 2; ++b)
#pragma unroll
                for (int m = 0; m < 4; ++m)
#pragma unroll
                    for (int n = 0; n < 2; ++n) acc[a][b][m][n] = (f32x4){0.f, 0.f, 0.f, 0.f};
        }
        cur = nxt; cA = nA; cB = nB; ++ui;
        if constexpr (ALIGN_EPI) { if (wr == 1) PG8_BAR; }
    }
    PG8_WAIT_V(0);
    if constexpr (!ALIGN_EPI) { if (wr == 0) PG8_BAR; }
    PG8_BAR;
#undef PG8_SA
#undef PG8_SB
#undef PG8_STAGE
#undef PG8_LDA
#undef PG8_LDB
#undef PG8_MMA
#undef PG8_KOFF
#undef PG8_NT
#undef PG8_WAIT_V
#undef PG8_WAIT_L
#undef PG8_BAR
#undef PG8_SCHED
}
}

#define XB_TMO      128
#define XB_XCNT(j)  (256  + 64 * (j))
#define XB_XSUB(j)  (1280 + 64 * (j))
#define XB_XGEN(j)  (2304 + 64 * (j))
#define XB_TOP      3328
#define XB_TOPGEN   3392
#define XCD_BAR_WORDS 3456
#define XB_SPIN_CAP (1u << 18)
__device__ __forceinline__ unsigned xb_ld(unsigned* p)              { return __hip_atomic_load(p, __ATOMIC_RELAXED, __HIP_MEMORY_SCOPE_AGENT); }
__device__ __forceinline__ unsigned xb_add(unsigned* p, unsigned v) { return __hip_atomic_fetch_add(p, v, __ATOMIC_RELAXED, __HIP_MEMORY_SCOPE_AGENT); }
__device__ __forceinline__ unsigned xb_xcc_id() { return (unsigned)__builtin_amdgcn_s_getreg((3 << 11) | 20) & 0xFu; }
#define XB_SPIN(cond, bar) do { unsigned _sp = 0; while (cond) { __builtin_amdgcn_s_sleep(1); \
    if ((++_sp & 255u) == 0u) { if (xb_ld(&(bar)[XB_TMO])) break; if (_sp > XB_SPIN_CAP) { atomicAdd(&(bar)[XB_TMO], 1u); break; } } } } while (0)
struct XcdBarrier { unsigned* bar; unsigned x; volatile LAS unsigned* st; };
__device__ __forceinline__ XcdBarrier xcd_barrier_post(unsigned* bar, volatile LAS unsigned* st) {
    XcdBarrier b; b.bar = bar; b.x = xb_xcc_id(); b.st = st;
    if (threadIdx.x == 0) (void)xb_add(&bar[XB_XCNT(b.x)], 1u);
    return b;
}
__device__ __forceinline__ void xcd_barrier_complete(unsigned* bar, unsigned x, unsigned& nloc, unsigned& nx) {
    const unsigned G = gridDim.x * gridDim.y * gridDim.z;
    unsigned sum, cnt, mine, sp = 0u;
    for (;;) {
        sum = 0u; cnt = 0u; mine = 0u;
#pragma unroll
        for (unsigned j = 0; j < 16; ++j) { const unsigned c = xb_ld(&bar[XB_XCNT(j)]); sum += c; cnt += (c > 0u) ? 1u : 0u; mine = (j == x) ? c : mine; }
        if (sum == G) break;
        __builtin_amdgcn_s_sleep(1);
        if ((++sp & 255u) == 0u) { if (xb_ld(&bar[XB_TMO])) break; if (sp > XB_SPIN_CAP) { atomicAdd(&bar[XB_TMO], 1u); break; } }
    }
    nloc = mine > 0u ? mine : 1u; nx = cnt > 0u ? cnt : 1u;
}
__device__ __forceinline__ void xcd_barrier(const XcdBarrier& b) {
    asm volatile("s_waitcnt vmcnt(0)" ::: "memory");
    __syncthreads();
    if (threadIdx.x == 0) {
        unsigned* bar = b.bar;
        __builtin_amdgcn_s_waitcnt(0);
        unsigned nloc = b.st[0], nx = b.st[1];
        if (nloc == 0u) { xcd_barrier_complete(bar, b.x, nloc, nx); b.st[0] = nloc; b.st[1] = nx; }
        const unsigned old = xb_add(&bar[XB_XSUB(b.x)], 1u);
        const unsigned gen = old / nloc;
        if (old + 1u == (gen + 1u) * nloc) {
            __builtin_amdgcn_fence(__ATOMIC_RELEASE, "agent");
            asm volatile("s_waitcnt vmcnt(0)" ::: "memory");
            const unsigned og = xb_add(&bar[XB_TOP], 1u);
            const unsigned tg = og / nx;
            if (og + 1u == (tg + 1u) * nx) xb_add(&bar[XB_TOPGEN], 1u);
            else XB_SPIN(xb_ld(&bar[XB_TOPGEN]) == tg, bar);
            __builtin_amdgcn_fence(__ATOMIC_ACQUIRE, "agent");
            xb_add(&bar[XB_XGEN(b.x)], 1u);
            asm volatile("s_waitcnt vmcnt(0)" ::: "memory");
        } else {
            XB_SPIN(xb_ld(&bar[XB_XGEN(b.x)]) == gen, bar);
            __builtin_amdgcn_fence(__ATOMIC_ACQUIRE, "agent");
            asm volatile("s_waitcnt vmcnt(0)" ::: "memory");
        }
    }
    __syncthreads();
}

constexpr int RING_BYTES = 131072;
constexpr int LDS_MISC = RING_BYTES + 2048;
constexpr int LDS_BYTES = 147456;
struct Args {
    const float* in[18]; float* out; unsigned char* ws;
    int l_lo, l_hi, ph_lo, ph_hi;
};
struct Frame {
    LAS unsigned char* lds;
    int G, bid;
};
typedef const __attribute__((address_space(4))) Args* KArgsP;
__device__ __forceinline__ KArgsP kargs() { KArgsP p = (KArgsP)__builtin_amdgcn_kernarg_segment_ptr(); asm volatile("" : "+s"(p)); return p; }
#define A_IN(i) (kargs()->in[i])
#define A_WS(T, off) ((T*)(kargs()->ws + (off)))
#define A_OUT (kargs()->out)
#define P_x A_IN(0)
#define P_rel_bias A_IN(1)
#define P_norm1_g A_IN(2)
#define P_w_in A_IN(3)
#define P_q_norm_g A_IN(4)
#define P_k_norm_g A_IN(5)
#define P_gla_gate_up A_IN(6)
#define P_gla_gate_b A_IN(7)
#define P_gla_out_g A_IN(8)
#define P_sgu_ln_g A_IN(9)
#define P_sgu_ln_b A_IN(10)
#define P_sgu_w A_IN(11)
#define P_sgu_b A_IN(12)
#define P_w_branch A_IN(13)
#define P_w_out A_IN(14)
#define P_norm2_g A_IN(15)
#define P_w_ffn_in A_IN(16)
#define P_w_ffn_out A_IN(17)
#define P_WIN A_WS(bf16_t, WS_WIN)
#define P_W8 A_WS(unsigned char, WS_W8)
#define P_XB8 A_WS(unsigned char, WS_XB8)
#define P_WBR A_WS(bf16_t, WS_WBR)
#define P_WO A_WS(bf16_t, WS_WO)
#define P_WFI A_WS(bf16_t, WS_WFI)
#define P_WFO A_WS(bf16_t, WS_WFO)
#define P_XN A_WS(bf16_t, WS_XN)
#define P_Y A_WS(bf16_t, WS_Y)
#define P_OMIX A_WS(bf16_t, WS_OMIX)
#define P_Z A_WS(bf16_t, WS_Z)
#define P_H A_WS(bf16_t, WS_Z)
#define P_SP A_WS(bf16_t, WS_SP)
#define P_QT A_WS(bf16_t, WS_QT)
#define P_KT A_WS(bf16_t, WS_KT)
#define P_AO ((bf16_t*)((unsigned char*)A_OUT + OUT_AO))
#define P_SL ((bf16_t*)((unsigned char*)A_OUT + OUT_SL))
#define P_DL A_WS(float, WS_DL)
#define P_LSE A_WS(float, WS_LSE)
#define P_out A_OUT
#define P_RS1 A_WS(rs_t, WS_RS1)
#define P_RS2 A_WS(rs_t, WS_RS2)

template <bool FP8OUT, class SrcCol>
__device__ __forceinline__ void transpose_item(const float* W, int ldw, void* WTv, int K, LAS float* scr, int item, int nblk, int lane, const float* gain, SrcCol srccol) {
    const int kb = item / nblk, nb = item % nblk, k0 = 64 * kb, n0 = 32 * nb;
    const int nq = lane & 7, kr = lane >> 3, sc = srccol(n0 + 4 * nq);
    f32x4 v[8]; float gk[8];
#pragma unroll
    for (int i = 0; i < 8; ++i) { const int kk = 8 * i + kr; v[i] = sc >= 0 ? *(const f32x4*)(W + (size_t)(k0 + kk) * ldw + sc) : (f32x4){0.f, 0.f, 0.f, 0.f}; gk[i] = gain ? gain[k0 + kk] : 1.0f; }
#pragma unroll
    for (int i = 0; i < 8; ++i) { const int kk = 8 * i + kr; LAS float* d = scr + kk * 33 + 4 * nq; d[0] = v[i].x * gk[i]; d[1] = v[i].y * gk[i]; d[2] = v[i].z * gk[i]; d[3] = v[i].w * gk[i]; }
    LDS_WAIT(); asm volatile("" ::: "memory");
    const int c = lane & 7;
#pragma unroll
    for (int j = 0; j < 4; ++j) { const int n = (lane >> 3) + 8 * j; const LAS float* s = scr + (8 * c) * 33 + n;
        if constexpr (FP8OUT) { u32x2 o; o.x = 0u; o.y = 0u;
            o.x = __builtin_amdgcn_cvt_pk_fp8_f32(s[0 * 33] * W8_SCALE, s[1 * 33] * W8_SCALE, o.x, false); o.x = __builtin_amdgcn_cvt_pk_fp8_f32(s[2 * 33] * W8_SCALE, s[3 * 33] * W8_SCALE, o.x, true);
            o.y = __builtin_amdgcn_cvt_pk_fp8_f32(s[4 * 33] * W8_SCALE, s[5 * 33] * W8_SCALE, o.y, false); o.y = __builtin_amdgcn_cvt_pk_fp8_f32(s[6 * 33] * W8_SCALE, s[7 * 33] * W8_SCALE, o.y, true);
            *(u32x2*)((unsigned char*)WTv + (size_t)(n0 + n) * K + k0 + 8 * c) = o; }
        else { u32x4 o; o.x = cvt_pk_bf16(s[0 * 33], s[1 * 33]); o.y = cvt_pk_bf16(s[2 * 33], s[3 * 33]); o.z = cvt_pk_bf16(s[4 * 33], s[5 * 33]); o.w = cvt_pk_bf16(s[6 * 33], s[7 * 33]);
            *(u32x4*)((bf16_t*)WTv + (size_t)(n0 + n) * K + k0 + 8 * c) = o; } }
    LDS_WAIT(); asm volatile("" ::: "memory");
}
__device__ __forceinline__ void cast_rows(Frame& F, const float* x, bf16_t* xb, rs_t* rs, unsigned char* xb8) {
    const int tid_ = opq_tid(), lane = tid_ & 63, wave = __builtin_amdgcn_readfirstlane(tid_ >> 6);
    const int gw = F.bid * NWAVES + wave, NGW = F.G * NWAVES;
    for (int m = gw; m < M; m += NGW) {
        const f32x4* xr = (const f32x4*)(x + (size_t)m * D) + lane;
        f32x4 v[8]; float s = 0.f;
#pragma unroll
        for (int j = 0; j < 8; ++j) { v[j] = xr[64 * j]; s += (v[j].x * v[j].x + v[j].y * v[j].y) + (v[j].z * v[j].z + v[j].w * v[j].w); }
        s = wave_sum(s);
        u32x2* o8 = (u32x2*)(xb + (size_t)m * D) + lane;
#pragma unroll
        for (int j = 0; j < 8; ++j) { u32x2 w; w.x = cvt_pk_bf16(v[j].x, v[j].y); w.y = cvt_pk_bf16(v[j].z, v[j].w); o8[64 * j] = w; }
        unsigned* o4 = (unsigned*)(xb8 + (size_t)m * D) + lane;
#pragma unroll
        for (int j = 0; j < 8; ++j) { unsigned q8 = 0u; q8 = __builtin_amdgcn_cvt_pk_fp8_f32(v[j].x, v[j].y, q8, false); q8 = __builtin_amdgcn_cvt_pk_fp8_f32(v[j].z, v[j].w, q8, true); o4[64 * j] = q8; }
        if (lane == 0) rs[m] = (rs_t)(s * RS_SCALE + 0.5f);
    }
}
struct TJob { const float* src; const float* gp; unsigned char* dst; int ldw, K; bool valid, fp8; };
__device__ __forceinline__ void tj_load(const TJob& j, f32x4 (&v)[8], float (&gk)[8]) {
#pragma unroll
    for (int i = 0; i < 8; ++i) { v[i] = j.valid ? *(const f32x4*)(j.src + (size_t)(8 * i) * j.ldw) : (f32x4){0.f, 0.f, 0.f, 0.f}; gk[i] = j.gp ? j.gp[8 * i] : 1.0f; }
}
__device__ __forceinline__ void tj_process(const TJob& j, const f32x4 (&v)[8], const float (&gk)[8], LAS float* scr, int lane) {
    const int nq = lane & 7, kr = lane >> 3;
#pragma unroll
    for (int i = 0; i < 8; ++i) { const int kk = 8 * i + kr; LAS float* d = scr + kk * 33 + 4 * nq; d[0] = v[i].x * gk[i]; d[1] = v[i].y * gk[i]; d[2] = v[i].z * gk[i]; d[3] = v[i].w * gk[i]; }
    LDS_WAIT(); asm volatile("" ::: "memory");
    const int c = lane & 7;
#pragma unroll
    for (int q = 0; q < 4; ++q) { const int n = (lane >> 3) + 8 * q; const LAS float* s = scr + (8 * c) * 33 + n;
        if (j.fp8) { u32x2 o; o.x = 0u; o.y = 0u;
            o.x = __builtin_amdgcn_cvt_pk_fp8_f32(s[0 * 33] * W8_SCALE, s[1 * 33] * W8_SCALE, o.x, false); o.x = __builtin_amdgcn_cvt_pk_fp8_f32(s[2 * 33] * W8_SCALE, s[3 * 33] * W8_SCALE, o.x, true);
            o.y = __builtin_amdgcn_cvt_pk_fp8_f32(s[4 * 33] * W8_SCALE, s[5 * 33] * W8_SCALE, o.y, false); o.y = __builtin_amdgcn_cvt_pk_fp8_f32(s[6 * 33] * W8_SCALE, s[7 * 33] * W8_SCALE, o.y, true);
            *(u32x2*)(j.dst + (size_t)(8 * q) * j.K) = o; }
        else { u32x4 o; o.x = cvt_pk_bf16(s[0 * 33], s[1 * 33]); o.y = cvt_pk_bf16(s[2 * 33], s[3 * 33]); o.z = cvt_pk_bf16(s[4 * 33], s[5 * 33]); o.w = cvt_pk_bf16(s[6 * 33], s[7 * 33]);
            *(u32x4*)(j.dst + (size_t)(16 * q) * j.K) = o; } }
    LDS_WAIT(); asm volatile("" ::: "memory");
}
__device__ __forceinline__ void p0_convert(Frame& F, int l) {
    const int tid_ = opq_tid(), lane = tid_ & 63, wave = __builtin_amdgcn_readfirstlane(tid_ >> 6);
    LAS float* scr = (LAS float*)(F.lds + wave * 16384);
    const int gw = F.bid * NWAVES + wave, NGW = F.G * NWAVES;
    constexpr int I_IN = (D / 64) * (NB / 32), I_8 = (D / 64) * (N8 / 32), I_BR = (D / 64) * (D / 32), I_O = I_BR, I_FI = (D / 64) * (NFI / 32), I_FO = (DFF / 64) * (D / 32);
    constexpr int NITEMS = I_IN + I_8 + I_BR + I_O + I_FI + I_FO;
    const int nq = lane & 7, kr = lane >> 3;
    auto describe = [&](int it) -> TJob {
        const float* w_in = P_w_in + (size_t)l * D * DIN; const float* w_br = P_w_branch + (size_t)l * D * D; const float* w_o = P_w_out + (size_t)l * D * D;
        const float* w_fi = P_w_ffn_in + (size_t)l * D * NFI; const float* w_fo = P_w_ffn_out + (size_t)l * DFF * D;
        auto fin = [&](const float* W, int ldw, void* WT, int K, int kb, int nb, const float* gain, int sc, bool fp8) -> TJob {
            TJob j; const int k0 = 64 * kb, n0 = 32 * nb;
            j.src = W + (size_t)(k0 + kr) * ldw + sc; j.gp = gain ? gain + k0 + kr : nullptr; j.ldw = ldw; j.K = K; j.valid = sc >= 0; j.fp8 = fp8;
            j.dst = (unsigned char*)WT + ((size_t)(n0 + (lane >> 3)) * K + k0 + 8 * (lane & 7)) * (fp8 ? 1 : 2); return j; };
        int r = it;
        if (r < I_IN) { const int nb = r % (NB / 32), n = 32 * nb + 4 * nq;
            return fin(w_in, DIN, P_WIN, D, r / (NB / 32), nb, P_norm1_g + l * D, n < 1536 ? 4608 + n : (n < 3072 ? 6160 + (n - 1536) : (n < 3088 ? 6144 + (n - 3072) : -1)), false); } r -= I_IN;
        if (r < I_8) { const int nb = r % (N8 / 32), n = 32 * nb + 4 * nq;
            return fin(w_in, DIN, P_W8, D, r / (N8 / 32), nb, P_norm1_g + l * D, n < 4608 ? n : 7696 + (n - 4608), true); } r -= I_8;
        if (r < I_BR) { const int nb = r % (D / 32); return fin(w_br, D, P_WBR, D, r / (D / 32), nb, nullptr, 32 * nb + 4 * nq, false); } r -= I_BR;
        if (r < I_O) { const int nb = r % (D / 32); return fin(w_o, D, P_WO, D, r / (D / 32), nb, nullptr, 32 * nb + 4 * nq, false); } r -= I_O;
        if (r < I_FI) { const int nb = r % (NFI / 32), n = 32 * nb + 4 * nq, t = n >> 8, jj = n & 255;
            return fin(w_fi, NFI, P_WFI, D, r / (NFI / 32), nb, P_norm2_g + l * D, jj < 128 ? 128 * t + jj : DFF + 128 * t + (jj - 128), false); } r -= I_FI;
        { const int nb = r % (D / 32); return fin(w_fo, D, P_WFO, DFF, r / (D / 32), nb, nullptr, 32 * nb + 4 * nq, false); }
    };
    f32x4 vA[8], vB[8]; float gA[8], gB[8]; TJob jA, jB;
    int it = gw;
    if (it < NITEMS) { jA = describe(it); tj_load(jA, vA, gA); }
    for (; it < NITEMS; it += 2 * NGW) {
        const bool hasB = it + NGW < NITEMS;
        if (hasB) { jB = describe(it + NGW); tj_load(jB, vB, gB); }
        tj_process(jA, vA, gA, scr, lane);
        if (it + 2 * NGW < NITEMS) { jA = describe(it + 2 * NGW); tj_load(jA, vA, gA); }
        if (hasB) tj_process(jB, vB, gB, scr, lane);
    }
}

__device__ __forceinline__ unsigned off_b(unsigned row, unsigned ch) { return 256u * row + 16u * (ch ^ (((row & 3u) << 2) | ((row >> 2) & 3u))); }
__device__ __forceinline__ s16x4 tr16(const LAS unsigned char* p) {
    typedef short v4i16_t __attribute__((ext_vector_type(4)));
    return __builtin_bit_cast(s16x4, __builtin_amdgcn_ds_read_tr16_b64_v4i16((LAS v4i16_t*)p));
}
__device__ __forceinline__ bf16x8 cat8(s16x4 a, s16x4 b) { return (bf16x8){a[0], a[1], a[2], a[3], b[0], b[1], b[2], b[3]}; }
__device__ __forceinline__ int t5_bucket(int td) {
    if (td < 16) return td;
    int b = 16;
    b += td >= 22; b += td >= 30; b += td >= 40; b += td >= 54; b += td >= 73; b += td >= 99; b += td >= 134; b += td >= 182;
    b += td >= 246; b += td >= 332; b += td >= 450; b += td >= 609; b += td >= 825; b += td >= 1117; b += td >= 1513;
    return b;
}
constexpr int ATT_K = 0, ATT_V = 65536, ATT_BIAS = 131072;
__device__ __forceinline__ void attn_norm_store(LAS unsigned char* Kimg, LAS unsigned char* Vimg, int row, int ch, u32x4 kv, u32x4 vv, f32x4 gk0, f32x4 gk1) {
    float kf[8] = {bflo(kv.x), bfhi(kv.x), bflo(kv.y), bfhi(kv.y), bflo(kv.z), bfhi(kv.z), bflo(kv.w), bfhi(kv.w)};
    float ss = 0.f;
#pragma unroll
    for (int j = 0; j < 8; ++j) ss += kf[j] * kf[j];
    ss += __shfl_xor(ss, 1); ss += __shfl_xor(ss, 2); ss += __shfl_xor(ss, 4); ss += __shfl_xor(ss, 8);
    const float rs = 1.0f / sqrtf(ss * (1.f / 128.f) + EPS);
    u32x4 ko; ko.x = cvt_pk_bf16(kf[0] * rs * gk0.x, kf[1] * rs * gk0.y); ko.y = cvt_pk_bf16(kf[2] * rs * gk0.z, kf[3] * rs * gk0.w);
    ko.z = cvt_pk_bf16(kf[4] * rs * gk1.x, kf[5] * rs * gk1.y); ko.w = cvt_pk_bf16(kf[6] * rs * gk1.z, kf[7] * rs * gk1.w);
    const unsigned o = off_b((unsigned)row, (unsigned)ch);
    *(LAS u32x4*)(Kimg + o) = ko; *(LAS u32x4*)(Vimg + o) = vv;
}
__device__ __forceinline__ void attn_seg(Frame& F, int seg, int l) {
    const int rnb = seg & 7, h = (seg >> 3) & 3, bg = seg >> 5, g = bg % 3, b = bg / 3;
    const int dsh = 2 * g, dil = 1 << dsh, nb = 32 >> dsh;
    const bf16_t* Zb = P_Z + (size_t)b * SEQ * NZ;
    const int qcol = g * 512 + h * 128;
    LAS unsigned char* Kimg = F.lds + ATT_K; LAS unsigned char* Vimg = F.lds + ATT_V; LAS float* biasT = (LAS float*)(F.lds + ATT_BIAS);
    const int tid = opq_tid(), lane = tid & 63, w = __builtin_amdgcn_readfirstlane(tid >> 6), fr = lane & 15, fq = lane >> 4;
    if (tid < 192) { const int d = tid - 32; biasT[tid] = (d >= 0 && d <= 128) ? P_rel_bias[t5_bucket(d << dsh) * 12 + g * 4 + h] : -3.0e38f; }
    LAS float* gqL = biasT + 256;
    if (tid >= 256 && tid < 384) gqL[tid - 256] = P_q_norm_g[l * 128 + (tid - 256)];
    const int ch = tid & 15, srow = tid >> 4;
    const f32x4 gk0 = *(const f32x4*)(P_k_norm_g + l * 128 + ch * 8), gk1 = *(const f32x4*)(P_k_norm_g + l * 128 + ch * 8 + 4);
    u32x4 kc[4], vc[4];
    {
        const int rn = 4 * rnb, r = rn / nb, n = rn % nb;
#pragma unroll
        for (int it = 0; it < 4; ++it) { const bf16_t* p = Zb + (size_t)((128 * n + it * 32 + srow) * dil + r) * NZ + qcol + ch * 8; kc[it] = *(const u32x4*)(p + ZK); vc[it] = *(const u32x4*)(p + ZV); }
    }
#pragma unroll 1
    for (int pos = 0; pos < 4; ++pos) {
        const int rn = 4 * rnb + pos, r = rn / nb, n = rn % nb;
        const int cs = (n & 1) << 7, ps = cs ^ 128;
        const int qi = 16 * w + fr, qtok = (128 * n + qi) * dil + r;
        const size_t qrow = (size_t)b * SEQ + qtok;
        u32x4 qv[4];
        { const bf16_t* qp = P_Z + qrow * NZ + ZQ + qcol + 8 * fq;
#pragma unroll
          for (int ks = 0; ks < 4; ++ks) qv[ks] = *(const u32x4*)(qp + 32 * ks); }
        if (n == 0) {
#pragma unroll
            for (int it = 0; it < 4; ++it) { const unsigned o = off_b((unsigned)(ps + it * 32 + srow), (unsigned)ch); *(LAS u32x4*)(Kimg + o) = (u32x4){0u, 0u, 0u, 0u}; *(LAS u32x4*)(Vimg + o) = (u32x4){0u, 0u, 0u, 0u}; }
        } else if (pos == 0) {
            u32x4 kp[4], vp[4];
#pragma unroll
            for (int it = 0; it < 4; ++it) { const bf16_t* p = Zb + (size_t)((128 * (n - 1) + it * 32 + srow) * dil + r) * NZ + qcol + ch * 8; kp[it] = *(const u32x4*)(p + ZK); vp[it] = *(const u32x4*)(p + ZV); }
#pragma unroll
            for (int it = 0; it < 4; ++it) attn_norm_store(Kimg, Vimg, ps + it * 32 + srow, ch, kp[it], vp[it], gk0, gk1);
        }
#pragma unroll
        for (int it = 0; it < 4; ++it) attn_norm_store(Kimg, Vimg, cs + it * 32 + srow, ch, kc[it], vc[it], gk0, gk1);
        if (pos < 3) {
            const int rn2 = rn + 1, r2 = rn2 / nb, n2 = rn2 % nb;
#pragma unroll
            for (int it = 0; it < 4; ++it) { const bf16_t* p = Zb + (size_t)((128 * n2 + it * 32 + srow) * dil + r2) * NZ + qcol + ch * 8; kc[it] = *(const u32x4*)(p + ZK); vc[it] = *(const u32x4*)(p + ZV); }
        }
        bf16x8 qf[4];
        {
            float ss = 0.f;
#pragma unroll
            for (int ks = 0; ks < 4; ++ks) {
                const float a0 = bflo(qv[ks].x), a1 = bfhi(qv[ks].x), a2 = bflo(qv[ks].y), a3 = bfhi(qv[ks].y), a4 = bflo(qv[ks].z), a5 = bfhi(qv[ks].z), a6 = bflo(qv[ks].w), a7 = bfhi(qv[ks].w);
                ss += (a0 * a0 + a1 * a1) + (a2 * a2 + a3 * a3) + (a4 * a4 + a5 * a5) + (a6 * a6 + a7 * a7); }
            ss += __shfl_xor(ss, 16); ss += __shfl_xor(ss, 32);
            const float rs = (1.0f / sqrtf(ss * (1.f / 128.f) + EPS)) * 0.08838834764831845f;
#pragma unroll
            for (int ks = 0; ks < 4; ++ks) { const f32x4 g0 = *(const LAS f32x4*)(gqL + 32 * ks + 8 * fq), g1 = *(const LAS f32x4*)(gqL + 32 * ks + 8 * fq + 4);
                u32x4 o; o.x = cvt_pk_bf16(bflo(qv[ks].x) * rs * g0.x, bfhi(qv[ks].x) * rs * g0.y); o.y = cvt_pk_bf16(bflo(qv[ks].y) * rs * g0.z, bfhi(qv[ks].y) * rs * g0.w);
                o.z = cvt_pk_bf16(bflo(qv[ks].z) * rs * g1.x, bfhi(qv[ks].z) * rs * g1.y); o.w = cvt_pk_bf16(bflo(qv[ks].w) * rs * g1.z, bfhi(qv[ks].w) * rs * g1.w);
                qf[ks] = __builtin_bit_cast(bf16x8, o); }
        }
        WG_SYNC();
        const int kb0 = w >> 1;
        f32x4 s[5][2];
#pragma unroll
        for (int kbi = 0; kbi < 5; ++kbi)
#pragma unroll
            for (int hb = 0; hb < 2; ++hb) {
                const unsigned krow = (unsigned)((32 * (kb0 + kbi) + 8 * (fr >> 2) + (fr & 3) + 4 * hb) ^ ps);
                f32x4 a = (f32x4){0.f, 0.f, 0.f, 0.f};
#pragma unroll
                for (int ks = 0; ks < 4; ++ks) { const bf16x8 kfr = *(const LAS bf16x8*)(Kimg + off_b(krow, (unsigned)(4 * ks + fq))); a = __builtin_amdgcn_mfma_f32_16x16x32_bf16(kfr, qf[ks], a, 0, 0, 0); }
                s[kbi][hb] = a;
            }
        float mx = -3.0e38f;
        const LAS float* bt = biasT + (qi + 160 - 32 * kb0 - 8 * fq);
        float bv[5][2][4];
#pragma unroll
        for (int kbi = 0; kbi < 5; ++kbi)
#pragma unroll
            for (int hb = 0; hb < 2; ++hb)
#pragma unroll
                for (int i = 0; i < 4; ++i) bv[kbi][hb][i] = bt[-(32 * kbi + 4 * hb + i)];
#pragma unroll
        for (int kbi = 0; kbi < 5; ++kbi) {
            const float dm = ((n == 0) && (kb0 + kbi < 4)) ? -3.0e38f : 0.f;
#pragma unroll
            for (int hb = 0; hb < 2; ++hb)
#pragma unroll
                for (int i = 0; i < 4; ++i) {
                    const float v = (s[kbi][hb][i] + bv[kbi][hb][i]) + dm;
                    s[kbi][hb][i] = v; mx = fmaxf(mx, v);
                }
        }
        mx = fmaxf(mx, __shfl_xor(mx, 16)); mx = fmaxf(mx, __shfl_xor(mx, 32));
        float sum = 0.f; bf16x8 pf[5];
#pragma unroll
        for (int kbi = 0; kbi < 5; ++kbi) {
            float p[8];
#pragma unroll
            for (int hb = 0; hb < 2; ++hb)
#pragma unroll
                for (int i = 0; i < 4; ++i) { const float e = __expf(s[kbi][hb][i] - mx); p[4 * hb + i] = e; sum += e; }
            u32x4 o; o.x = cvt_pk_bf16(p[0], p[1]); o.y = cvt_pk_bf16(p[2], p[3]); o.z = cvt_pk_bf16(p[4], p[5]); o.w = cvt_pk_bf16(p[6], p[7]);
            pf[kbi] = __builtin_bit_cast(bf16x8, o);
        }
        sum += __shfl_xor(sum, 16); sum += __shfl_xor(sum, 32);
        const float inv = 1.0f / sum;
        bf16_t* op = P_AO + ((size_t)g * M + qrow) * 512 + h * 128 + 8 * fq;
        const unsigned tq = (unsigned)((lane & 15) >> 2), tp = (unsigned)(lane & 3);
#pragma unroll
        for (int cp = 0; cp < 4; ++cp) {
            f32x4 o0 = (f32x4){0.f, 0.f, 0.f, 0.f}, o1 = (f32x4){0.f, 0.f, 0.f, 0.f};
#pragma unroll
            for (int kbi = 0; kbi < 5; ++kbi) {
                const unsigned r0 = ((unsigned)(32 * (kb0 + kbi) + 8 * fq) + tq) ^ (unsigned)ps;
                const LAS unsigned char* a0 = Vimg + off_b(r0, (unsigned)(4 * cp) + tp); const LAS unsigned char* a1 = Vimg + off_b(r0 + 4u, (unsigned)(4 * cp) + tp);
                o0 = __builtin_amdgcn_mfma_f32_16x16x32_bf16(cat8(tr16(a0), tr16(a1)), pf[kbi], o0, 0, 0, 0);
                o1 = __builtin_amdgcn_mfma_f32_16x16x32_bf16(cat8(tr16(a0 + 8), tr16(a1 + 8)), pf[kbi], o1, 0, 0, 0);
            }
            u32x4 wv; wv.x = cvt_pk_bf16(o0[0] * inv, o0[1] * inv); wv.y = cvt_pk_bf16(o0[2] * inv, o0[3] * inv); wv.z = cvt_pk_bf16(o1[0] * inv, o1[1] * inv); wv.w = cvt_pk_bf16(o1[2] * inv, o1[3] * inv);
            *(u32x4*)(op + 32 * cp) = wv;
        }
        if (fq == 0) P_LSE[((size_t)g * M + qrow) * 4 + h] = mx + __logf(sum);
        WG_SYNC();
    }
}

constexpr int G1_P = 208;
constexpr int G1_QS = 0, G1_KS = 64 * G1_P, G1_KH = 2 * 64 * G1_P;
constexpr int G1_V = 3 * 64 * G1_P;
constexpr int G1_V_P = 400;
constexpr int G1_GL = G1_V + 64 * G1_V_P;
constexpr int G1_TOT = G1_GL + 4096;
constexpr int G1_END = G1_TOT + 1536;
__device__ __forceinline__ bf16x8 tr_frag(const LAS unsigned char* img, int pitch, int row0, int col0, int lane) {
    const int g = lane >> 4, q = (lane & 15) >> 2, p = lane & 3;
    const LAS unsigned char* a = img + (row0 + 8 * g + q) * pitch + (col0 + 4 * p) * 2;
    return cat8(tr16(a), tr16(a + 4 * pitch));
}
__device__ __forceinline__ void gla1_unit(Frame& F, int unit, int l) {
    const int h = unit & 3, c = (unit >> 2) & 63, b = unit >> 8;
    const size_t row0 = (size_t)b * SEQ + 64 * c;
    const bf16_t* Zr = P_Z + row0 * NZ;
    const int tid = opq_tid(), lane = tid & 63, w = __builtin_amdgcn_readfirstlane(tid >> 6);
    LAS unsigned char* QS = F.lds + G1_QS; LAS unsigned char* KS = F.lds + G1_KS; LAS unsigned char* KH = F.lds + G1_KH; LAS unsigned char* VI = F.lds + G1_V;
    LAS float* GLs = (LAS float*)(F.lds + G1_GL); LAS float* TOT = (LAS float*)(F.lds + G1_TOT);
    const int k = tid & 127, tg = tid >> 7;
    const bool act = k < GLA_DK;
    const int kc = act ? k : 0;
    {
        const int t = tid >> 3, j2 = (tid & 7) * 2; const unsigned gw2 = *(const unsigned*)(Zr + (size_t)t * NZ + ZGL + j2);
        u32x4 vv[3], qq[2], kk[2];
#pragma unroll
        for (int i = 0; i < 3; ++i) { const int idx = tid + 512 * i, sr = idx / 24, ch = idx % 24; vv[i] = *(const u32x4*)(Zr + (size_t)sr * NZ + ZBV + h * GLA_DV + ch * 8); }
#pragma unroll
        for (int i = 0; i < 2; ++i) { const int idx = tid + 512 * i; if (idx < 768) { const int sr = idx / 12, ch = idx % 12; const bf16_t* p = Zr + (size_t)sr * NZ + h * GLA_DK + ch * 8; qq[i] = *(const u32x4*)(p + ZBQ); kk[i] = *(const u32x4*)(p + ZBK); } }
        GLs[t * 16 + j2] = bflo(gw2); GLs[t * 16 + j2 + 1] = bfhi(gw2);
#pragma unroll
        for (int i = 0; i < 3; ++i) { const int idx = tid + 512 * i, sr = idx / 24, ch = idx % 24; *(LAS u32x4*)(VI + sr * G1_V_P + ch * 16) = vv[i]; }
#pragma unroll
        for (int i = 0; i < 2; ++i) { const int idx = tid + 512 * i; if (idx < 768) { const int sr = idx / 12, ch = idx % 12; *(LAS u32x4*)(QS + sr * G1_P + ch * 16) = qq[i]; *(LAS u32x4*)(KS + sr * G1_P + ch * 16) = kk[i]; } }
    }
    float wu[16];
#pragma unroll
    for (int j = 0; j < 16; ++j) wu[j] = P_gla_gate_up[((size_t)l * 16 + j) * 384 + h * GLA_DK + kc];
    const float bg = P_gla_gate_b[l * 384 + h * GLA_DK + kc];
    WG_SYNC();
    float bcum[16];
    {
        float run = 0.f;
#pragma unroll
        for (int i = 0; i < 16; ++i) {
            const LAS f32x4* gp = (const LAS f32x4*)(GLs + (16 * tg + i) * 16);
            const f32x4 g0 = gp[0], g1 = gp[1], g2 = gp[2], g3 = gp[3];
            float xg = bg + g0.x * wu[0] + g0.y * wu[1] + g0.z * wu[2] + g0.w * wu[3] + g1.x * wu[4] + g1.y * wu[5] + g1.z * wu[6] + g1.w * wu[7]
                     + g2.x * wu[8] + g2.y * wu[9] + g2.z * wu[10] + g2.w * wu[11] + g3.x * wu[12] + g3.y * wu[13] + g3.z * wu[14] + g3.w * wu[15];
            const float ls = fminf(xg, 0.f) - __logf(1.0f + __expf(-fabsf(xg)));
            run += ls * (1.0f / 16.0f); bcum[i] = run;
        }
        if (act) TOT[tg * GLA_DK + k] = run;
    }
    WG_SYNC();
    {
        float offs = 0.f, blast = 0.f;
#pragma unroll
        for (int q = 0; q < 4; ++q) { const float tv = TOT[q * GLA_DK + kc]; blast += tv; offs += q < tg ? tv : 0.f; }
        if (act) {
            if (tg == 0) P_DL[(size_t)unit * GLA_DK + k] = __expf(blast);
#pragma unroll
            for (int i = 0; i < 16; ++i) {
                const int t = 16 * tg + i; const float bb = bcum[i] + offs;
                LAS bf16_t* qa = (LAS bf16_t*)(QS + t * G1_P + k * 2); LAS bf16_t* ka = (LAS bf16_t*)(KS + t * G1_P + k * 2);
                const float qv = bflo((unsigned)*qa), kv = bflo((unsigned)*ka);
                *qa = (bf16_t)(cvt_pk_bf16(qv * 0.10206207261596575f * __expf(bb), 0.f) & 0xffffu);
                *ka = (bf16_t)(cvt_pk_bf16(kv * __expf(-bb), 0.f) & 0xffffu);
                *(LAS bf16_t*)(KH + t * G1_P + k * 2) = (bf16_t)(cvt_pk_bf16(kv * __expf(blast - bb), 0.f) & 0xffffu);
            }
        }
    }
    WG_SYNC();
    {
        bf16_t* QTp = P_QT; bf16_t* KTp = P_KT;
#pragma unroll
        for (int i = 0; i < 2; ++i) { const int idx = tid + 512 * i; if (idx < 768) { const int sr = idx / 12, ch = idx % 12; const size_t go = (row0 + sr) * 384 + h * GLA_DK + ch * 8;
            *(u32x4*)(QTp + go) = *(const LAS u32x4*)(QS + sr * G1_P + ch * 16); *(u32x4*)(KTp + go) = *(const LAS u32x4*)(KS + sr * G1_P + ch * 16); } }
    }
    bf16_t* SLu = P_SL + (size_t)unit * GLA_DV * GLA_DK;
    const int fr = lane & 15, fq = lane >> 4;
#pragma unroll 3
    for (int j = 0; j < 9; ++j) {
        const int tau = 9 * w + j, vt = tau / 6, kt = tau % 6;
        f32x4 a = (f32x4){0.f, 0.f, 0.f, 0.f};
#pragma unroll
        for (int ks = 0; ks < 2; ++ks) {
            const bf16x8 af = tr_frag(VI, G1_V_P, 32 * ks, 16 * vt, lane);
            const bf16x8 bfv = tr_frag(KH, G1_P, 32 * ks, 16 * kt, lane);
            a = __builtin_amdgcn_mfma_f32_16x16x32_bf16(bfv, af, a, 0, 0, 0);
        }
        { u32x2 wv; wv.x = cvt_pk_bf16(a[0], a[1]); wv.y = cvt_pk_bf16(a[2], a[3]); *(u32x2*)(SLu + (size_t)(16 * vt + fr) * GLA_DK + 16 * kt + 4 * fq) = wv; }
    }
    WG_SYNC();
}
__device__ __forceinline__ void gla_scan(Frame& F) {
    const int ntask = BATCH * 4 * GLA_DV * 12;
    const bf16_t* SLp = P_SL; const float* DLp = P_DL; bf16_t* SPp = P_SP;
    for (int task = F.bid * NT + opq_tid(); task < ntask; task += F.G * NT) {
        const int ko = task % 12, vd = (task / 12) % GLA_DV, bh = task / (12 * GLA_DV), h = bh & 3, b = bh >> 2;
        float st[8];
#pragma unroll
        for (int j = 0; j < 8; ++j) st[j] = 0.f;
#pragma unroll 4
        for (int c = 0; c < NCHK; ++c) {
            const size_t unit = ((size_t)b * NCHK + c) * 4 + h;
            const size_t e = (unit * GLA_DV + vd) * GLA_DK + ko * 8;
            const u32x4 sw = *(const u32x4*)(SLp + e); const f32x4 s0 = (f32x4){bflo(sw.x), bfhi(sw.x), bflo(sw.y), bfhi(sw.y)}, s1 = (f32x4){bflo(sw.z), bfhi(sw.z), bflo(sw.w), bfhi(sw.w)};
            const f32x4 d0 = *(const f32x4*)(DLp + unit * GLA_DK + ko * 8), d1 = *(const f32x4*)(DLp + unit * GLA_DK + ko * 8 + 4);
            u32x4 o; o.x = cvt_pk_bf16(st[0], st[1]); o.y = cvt_pk_bf16(st[2], st[3]); o.z = cvt_pk_bf16(st[4], st[5]); o.w = cvt_pk_bf16(st[6], st[7]);
            *(u32x4*)(SPp + e) = o;
            st[0] = d0.x * st[0] + s0.x; st[1] = d0.y * st[1] + s0.y; st[2] = d0.z * st[2] + s0.z; st[3] = d0.w * st[3] + s0.w;
            st[4] = d1.x * st[4] + s1.x; st[5] = d1.y * st[5] + s1.y; st[6] = d1.z * st[6] + s1.z; st[7] = d1.w * st[7] + s1.w;
        }
    }
}
constexpr int G3_V_P = 400;
__device__ __forceinline__ void gla3_unit(Frame& F, int unit, int l) {
    const int cp = unit & 31, h = (unit >> 5) & 3, b = unit >> 7;
    const int tid = opq_tid(), lane = tid & 63, w = __builtin_amdgcn_readfirstlane(tid >> 6), fr = lane & 15, fq = lane >> 4;
    const int cw = w >> 2, tt = w & 3, c = 2 * cp + cw;
    const size_t row0 = (size_t)b * SEQ + 64 * c;
    LAS unsigned char* VI = F.lds + cw * (64 * G3_V_P);
    u32x4 vreg[6];
    {
        const int lt = tid & 255; const bf16_t* Zr = P_Z + row0 * NZ + ZBV + h * GLA_DV;
#pragma unroll
        for (int i = 0; i < 6; ++i) { const int idx = lt + 256 * i, sr = idx / 24, ch = idx % 24; vreg[i] = *(const u32x4*)(Zr + (size_t)sr * NZ + ch * 8); }
    }
    bf16x8 qf[3];
    { const bf16_t* qp = P_QT + (row0 + 16 * tt + fr) * 384 + h * GLA_DK + 8 * fq;
#pragma unroll
      for (int ks = 0; ks < 3; ++ks) qf[ks] = *(const bf16x8*)(qp + 32 * ks); }
    bf16x8 pf[2];
    const int nblk = (tt >> 1) + 1;
#pragma unroll
    for (int blk = 0; blk < 2; ++blk) {
        u32x4 pw = (u32x4){0u, 0u, 0u, 0u};
        if (blk < nblk) {
            float p[8];
#pragma unroll
            for (int hb = 0; hb < 2; ++hb) {
                const int srow = 32 * blk + 8 * (fr >> 2) + (fr & 3) + 4 * hb;
                const bf16_t* kp = P_KT + (row0 + srow) * 384 + h * GLA_DK + 8 * fq;
                f32x4 a = (f32x4){0.f, 0.f, 0.f, 0.f};
#pragma unroll
                for (int ks = 0; ks < 3; ++ks) a = __builtin_amdgcn_mfma_f32_16x16x32_bf16(*(const bf16x8*)(kp + 32 * ks), qf[ks], a, 0, 0, 0);
#pragma unroll
                for (int i = 0; i < 4; ++i) { const int sidx = 32 * blk + 8 * fq + 4 * hb + i; p[4 * hb + i] = sidx <= 16 * tt + fr ? a[i] : 0.f; }
            }
            pw.x = cvt_pk_bf16(p[0], p[1]); pw.y = cvt_pk_bf16(p[2], p[3]); pw.z = cvt_pk_bf16(p[4], p[5]); pw.w = cvt_pk_bf16(p[6], p[7]);
        }
        pf[blk] = __builtin_bit_cast(bf16x8, pw);
    }
    const size_t gu = ((size_t)b * NCHK + c) * 4 + h;
    const bf16_t* SPu = P_SP + gu * GLA_DV * GLA_DK;
    f32x4 o[12];
#pragma unroll
    for (int vt = 0; vt < 12; ++vt) {
        f32x4 a = (f32x4){0.f, 0.f, 0.f, 0.f};
        const bf16_t* sp = SPu + (size_t)(16 * vt + fr) * GLA_DK + 8 * fq;
#pragma unroll
        for (int ks = 0; ks < 3; ++ks) a = __builtin_amdgcn_mfma_f32_16x16x32_bf16(*(const bf16x8*)(sp + 32 * ks), qf[ks], a, 0, 0, 0);
        o[vt] = a;
    }
    {
        const int lt = tid & 255;
#pragma unroll
        for (int i = 0; i < 6; ++i) { const int idx = lt + 256 * i, sr = idx / 24, ch = idx % 24; *(LAS u32x4*)(VI + sr * G3_V_P + ch * 16) = vreg[i]; }
    }
    WG_SYNC();
    float ss = 0.f;
#pragma unroll
    for (int vt = 0; vt < 12; ++vt) {
        f32x4 a = o[vt];
#pragma unroll
        for (int blk = 0; blk < 2; ++blk) { const bf16x8 vf = tr_frag(VI, G3_V_P, 32 * blk, 16 * vt, lane); a = __builtin_amdgcn_mfma_f32_16x16x32_bf16(vf, pf[blk], a, 0, 0, 0); }
        o[vt] = a; ss += (a[0] * a[0] + a[1] * a[1]) + (a[2] * a[2] + a[3] * a[3]);
    }
    ss += __shfl_xor(ss, 16); ss += __shfl_xor(ss, 32);
    const float rs = 1.0f / sqrtf(ss * (1.f / GLA_DV) + EPS);
    bf16_t* op = P_OMIX + (row0 + 16 * tt + fr) * D + 512 + h * GLA_DV + 4 * fq;
    const float* go = P_gla_out_g + l * GLA_DV + 4 * fq;
#pragma unroll
    for (int vt = 0; vt < 12; ++vt) { const f32x4 gv = *(const f32x4*)(go + 16 * vt);
        u32x2 wv; wv.x = cvt_pk_bf16(o[vt][0] * rs * gv.x, o[vt][1] * rs * gv.y); wv.y = cvt_pk_bf16(o[vt][2] * rs * gv.z, o[vt][3] * rs * gv.w);
        *(u32x2*)(op + 16 * vt) = wv; }
    WG_SYNC();
}

constexpr int SG_V_P = 400;
constexpr int SG_ST = 128 * SG_V_P;
__device__ __forceinline__ void sgu_unit(Frame& F, int unit, int l) {
    const int n = unit & 31, b = unit >> 5;
    const size_t row0 = (size_t)b * SEQ + 128 * n;
    const bf16_t* Zr = P_Z + row0 * NZ;
    const int tid = opq_tid(), lane = tid & 63, w = __builtin_amdgcn_readfirstlane(tid >> 6), fr = lane & 15, fq = lane >> 4;
    LAS unsigned char* VN = F.lds; LAS float* ST = (LAS float*)(F.lds + SG_ST);
    {
        const int t = tid >> 2, qd = tid & 3; const bf16_t* p = Zr + (size_t)t * NZ + ZCV + 192 * qd;
        float s1 = 0.f, s2 = 0.f;
#pragma unroll
        for (int hb = 0; hb < 2; ++hb) {
            u32x4 v[12];
#pragma unroll
            for (int c = 0; c < 12; ++c) v[c] = *(const u32x4*)(p + 96 * hb + 8 * c);
#pragma unroll
            for (int c = 0; c < 12; ++c) {
                const float a0 = gelu_tanh(bflo(v[c].x)), a1 = gelu_tanh(bfhi(v[c].x)), a2 = gelu_tanh(bflo(v[c].y)), a3 = gelu_tanh(bfhi(v[c].y));
                const float a4 = gelu_tanh(bflo(v[c].z)), a5 = gelu_tanh(bfhi(v[c].z)), a6 = gelu_tanh(bflo(v[c].w)), a7 = gelu_tanh(bfhi(v[c].w));
                s1 += ((a0 + a1) + (a2 + a3)) + ((a4 + a5) + (a6 + a7)); s2 += ((a0 * a0 + a1 * a1) + (a2 * a2 + a3 * a3)) + ((a4 * a4 + a5 * a5) + (a6 * a6 + a7 * a7)); }
        }
        s1 += __shfl_xor(s1, 1); s1 += __shfl_xor(s1, 2); s2 += __shfl_xor(s2, 1); s2 += __shfl_xor(s2, 2);
        const float mean = s1 * (1.f / 768.f), var = fmaxf(s2 * (1.f / 768.f) - mean * mean, 0.f);
        if (qd == 0) { ST[2 * t] = mean; ST[2 * t + 1] = 1.0f / sqrtf(var + EPS); }
    }
    WG_SYNC();
#pragma unroll 1
    for (int g = 0; g < 4; ++g) {
        {
            u32x4 v[6];
#pragma unroll
            for (int i = 0; i < 6; ++i) { const int idx = tid + 512 * i, sr = idx / 24, ch = idx % 24; v[i] = *(const u32x4*)(Zr + (size_t)sr * NZ + ZCV + g * 192 + ch * 8); }
#pragma unroll
            for (int i = 0; i < 6; ++i) { const int idx = tid + 512 * i, sr = idx / 24, ch = idx % 24;
                const float mean = ST[2 * sr], rstd = ST[2 * sr + 1];
                const float* lg = P_sgu_ln_g + l * 768 + g * 192 + ch * 8; const float* lb = P_sgu_ln_b + l * 768 + g * 192 + ch * 8;
                const f32x4 g0 = *(const f32x4*)lg, g1 = *(const f32x4*)(lg + 4), b0 = *(const f32x4*)lb, b1 = *(const f32x4*)(lb + 4);
                u32x4 o;
                o.x = cvt_pk_bf16((gelu_tanh(bflo(v[i].x)) - mean) * rstd * g0.x + b0.x, (gelu_tanh(bfhi(v[i].x)) - mean) * rstd * g0.y + b0.y);
                o.y = cvt_pk_bf16((gelu_tanh(bflo(v[i].y)) - mean) * rstd * g0.z + b0.z, (gelu_tanh(bfhi(v[i].y)) - mean) * rstd * g0.w + b0.w);
                o.z = cvt_pk_bf16((gelu_tanh(bflo(v[i].z)) - mean) * rstd * g1.x + b1.x, (gelu_tanh(bfhi(v[i].z)) - mean) * rstd * g1.y + b1.y);
                o.w = cvt_pk_bf16((gelu_tanh(bflo(v[i].w)) - mean) * rstd * g1.z + b1.z, (gelu_tanh(bfhi(v[i].w)) - mean) * rstd * g1.w + b1.w);
                *(LAS u32x4*)(VN + sr * SG_V_P + ch * 16) = o; }
        }
        WG_SYNC();
        const float* Wg = P_sgu_w + ((size_t)l * 4 + g) * 128 * 128;
#pragma unroll 1
        for (int half = 0; half < 2; ++half) {
            const int tt = half == 0 ? w : 7 - w, nks = (tt >> 1) + 1, t = 16 * tt + fr;
            bf16x8 wf[4];
#pragma unroll
            for (int ks = 0; ks < 4; ++ks) {
                u32x4 pw = (u32x4){0u, 0u, 0u, 0u};
                if (ks < nks) { const float* wp = Wg + (size_t)t * 128 + 32 * ks + 8 * fq; const f32x4 a = *(const f32x4*)wp, c4 = *(const f32x4*)(wp + 4); const int s0 = 32 * ks + 8 * fq;
                    pw.x = cvt_pk_bf16(s0 + 0 <= t ? a.x : 0.f, s0 + 1 <= t ? a.y : 0.f); pw.y = cvt_pk_bf16(s0 + 2 <= t ? a.z : 0.f, s0 + 3 <= t ? a.w : 0.f);
                    pw.z = cvt_pk_bf16(s0 + 4 <= t ? c4.x : 0.f, s0 + 5 <= t ? c4.y : 0.f); pw.w = cvt_pk_bf16(s0 + 6 <= t ? c4.z : 0.f, s0 + 7 <= t ? c4.w : 0.f); }
                wf[ks] = __builtin_bit_cast(bf16x8, pw);
            }
            const float bs = P_sgu_b[((size_t)l * 4 + g) * 128 + t];
            const bf16_t* up = Zr + (size_t)t * NZ + ZCU + g * 192 + 4 * fq;
            bf16_t* op = P_OMIX + (row0 + t) * D + 1280 + g * 192 + 4 * fq;
            u32x2 uv[6];
#pragma unroll
            for (int ci = 0; ci < 6; ++ci) uv[ci] = *(const u32x2*)(up + 16 * (6 * half + ci));
#pragma unroll
            for (int ci = 0; ci < 6; ++ci) {
                const int ct = 6 * half + ci;
                f32x4 a = (f32x4){0.f, 0.f, 0.f, 0.f};
#pragma unroll
                for (int ks = 0; ks < 4; ++ks) if (ks < nks) a = __builtin_amdgcn_mfma_f32_16x16x32_bf16(tr_frag(VN, SG_V_P, 32 * ks, 16 * ct, lane), wf[ks], a, 0, 0, 0);
                u32x2 wv; wv.x = cvt_pk_bf16(gelu_tanh(bflo(uv[ci].x)) * (a[0] + bs), gelu_tanh(bfhi(uv[ci].x)) * (a[1] + bs)); wv.y = cvt_pk_bf16(gelu_tanh(bflo(uv[ci].y)) * (a[2] + bs), gelu_tanh(bfhi(uv[ci].y)) * (a[3] + bs));
                *(u32x2*)(op + 16 * ct) = wv;
            }
        }
        WG_SYNC();
    }
}
__device__ __forceinline__ void attn_combine(Frame& F) {
    const size_t ntask = (size_t)M * 64;
    const float* LSEp = P_LSE; const bf16_t* AOp = P_AO; bf16_t* OMp = P_OMIX;
    for (size_t task = (size_t)F.bid * NT + opq_tid(); task < ntask; task += (size_t)F.G * NT) {
        const size_t row = task >> 6; const int ch = (int)(task & 63), h = ch >> 4;
        const float l0 = LSEp[((size_t)0 * M + row) * 4 + h], l1 = LSEp[((size_t)1 * M + row) * 4 + h], l2 = LSEp[((size_t)2 * M + row) * 4 + h];
        const float mx = fmaxf(l0, fmaxf(l1, l2)); const float e0 = __expf(l0 - mx), e1 = __expf(l1 - mx), e2 = __expf(l2 - mx); const float inv = 1.0f / (e0 + e1 + e2);
        const float w0 = e0 * inv, w1 = e1 * inv, w2 = e2 * inv;
        const u32x4 a = *(const u32x4*)(AOp + ((size_t)0 * M + row) * 512 + ch * 8), bq = *(const u32x4*)(AOp + ((size_t)1 * M + row) * 512 + ch * 8), cq = *(const u32x4*)(AOp + ((size_t)2 * M + row) * 512 + ch * 8);
        u32x4 o;
        o.x = cvt_pk_bf16(w0 * bflo(a.x) + w1 * bflo(bq.x) + w2 * bflo(cq.x), w0 * bfhi(a.x) + w1 * bfhi(bq.x) + w2 * bfhi(cq.x));
        o.y = cvt_pk_bf16(w0 * bflo(a.y) + w1 * bflo(bq.y) + w2 * bflo(cq.y), w0 * bfhi(a.y) + w1 * bfhi(bq.y) + w2 * bfhi(cq.y));
        o.z = cvt_pk_bf16(w0 * bflo(a.z) + w1 * bflo(bq.z) + w2 * bflo(cq.z), w0 * bfhi(a.z) + w1 * bfhi(bq.z) + w2 * bfhi(cq.z));
        o.w = cvt_pk_bf16(w0 * bflo(a.w) + w1 * bflo(bq.w) + w2 * bflo(cq.w), w0 * bfhi(a.w) + w1 * bfhi(bq.w) + w2 * bfhi(cq.w));
        *(u32x4*)(OMp + row * D + ch * 8) = o;
    }
}

constexpr int NPH = 10;
__global__ void __launch_bounds__(NT, 2) mega_fwd(Args args) {
    extern __shared__ __attribute__((aligned(16))) unsigned char lds_raw[];
    Frame F;
    F.lds = (LAS unsigned char*)lds_raw;
    F.G = gridDim.x; F.bid = blockIdx.x;
    unsigned char* ws = args.ws;
    volatile LAS unsigned* MISC = (volatile LAS unsigned*)(F.lds + LDS_MISC);
    if (threadIdx.x < 16) MISC[threadIdx.x] = 0u;
    __syncthreads();
    unsigned* ctl = (unsigned*)(ws + WS_CTL);
    const bool single = (args.ph_hi - args.ph_lo) > 1 || (args.l_hi - args.l_lo) > 1;
    XcdBarrier bar; bar.bar = ctl + CW_BAR; bar.x = 0; bar.st = nullptr;
    if (single) bar = xcd_barrier_post(ctl + CW_BAR, MISC);
#ifndef REP_MIX
#define REP_MIX 1
#endif
#ifndef REP_G1
#define REP_G1 1
#endif
#ifndef REP_THIN
#define REP_THIN 1
#endif
#ifndef REP_ATT
#define REP_ATT 1
#endif
#ifndef REP_GLA1
#define REP_GLA1 1
#endif
#ifndef REP_SGU
#define REP_SGU 1
#endif
#ifndef REP_SCAN
#define REP_SCAN 1
#endif
#ifndef REP_G3
#define REP_G3 1
#endif
#ifndef REP_CMB
#define REP_CMB 1
#endif
#ifndef REP_P5
#define REP_P5 1
#endif
#ifndef REP_P8
#define REP_P8 1
#endif
#ifndef PH_MASK
#define PH_MASK 0x3ff
#endif
#define IN(k) (((PH_MASK >> (k)) & 1) && args.ph_lo <= (k) && (k) < args.ph_hi)
#define GRID_BAR() do { if (single) xcd_barrier(bar); } while (0)

    for (int l = args.l_lo; l < args.l_hi; ++l) {
        for (int rp = 0; rp < REP_THIN; ++rp)
        if (IN(0)) { p0_convert(F, l); if (l == 0) cast_rows(F, P_x, P_XN, P_RS1, P_XB8); GRID_BAR(); }
        for (int rp = 0; rp < REP_G1; ++rp)
        if (IN(1)) {
            {
                pg8::Gemm g{P_XB8, P_W8, M, N8, D, D, D}; pg8::StaticOrder S; S.init(M, N8, F.G, F.bid); S.wgm = 8;
                if (F.G == 256) { S.full = 20; S.c0 = 128; S.extra = 2; }
                pg8::EpiStoreBf16 E{P_Z, NZ, P_RS1 + (size_t)l * M, 18, 0, ZGA, W8_INV};
                pg8::gemm_phase<pg8::EpiStoreBf16, true, true>(F.lds, g, S, E);
            }
            {
                pg8::Gemm g{P_XN, P_WIN, M, NB, D, D, D}; pg8::StaticOrder S; S.init(M, NB, F.G, F.bid); S.wgm = 8;
                pg8::EpiStoreBf16 E{P_Z, NZ, P_RS1 + (size_t)l * M, 12, ZBQ, ZGL, 1.0f};
                pg8::gemm_phase<pg8::EpiStoreBf16, true, false>(F.lds, g, S, E);
            }
            GRID_BAR();
        }
        for (int rp = 0; rp < REP_MIX; ++rp) {
        if (IN(2)) {
            for (int q = 0; q < REP_ATT; ++q) for (int u = F.bid; u < 768; u += F.G) attn_seg(F, u, l);
            for (int q = 0; q < REP_GLA1; ++q) for (int u = F.bid; u < 2048; u += F.G) gla1_unit(F, u, l);
            for (int q = 0; q < REP_SGU; ++q) for (int u = F.bid; u < 256; u += F.G) sgu_unit(F, u, l);
            GRID_BAR();
        }
        if (IN(3)) { for (int q = 0; q < REP_SCAN; ++q) gla_scan(F); GRID_BAR(); }
        if (IN(4)) {
            for (int q = 0; q < REP_G3; ++q) for (int u = F.bid; u < 1024; u += F.G) gla3_unit(F, u, l);
            for (int q = 0; q < REP_CMB; ++q) attn_combine(F);
            GRID_BAR();
        }
        }
        for (int rp = 0; rp < REP_P5; ++rp)
        if (IN(5)) {
            {
                pg8::Gemm g{P_OMIX, P_WBR, M, D, D, D, D}; pg8::StaticOrder S; S.init(M, D, F.G, F.bid); S.nbr = 3;
                pg8::EpiGate E{P_Y, P_Z + ZGA, D, NZ};
                pg8::gemm_phase<pg8::EpiGate, true, false, true>(F.lds, g, S, E);
            }
            GRID_BAR();
        }
        if (IN(6)) {
            pg8::Gemm g{P_Y, P_WO, M, D, D, D, D}; pg8::StaticOrder S; S.init(M, D, F.G, F.bid);
            pg8::EpiRes E{P_XN, (float*)nullptr, D, P_RS2 + (size_t)l * M, (unsigned char*)nullptr};
            pg8::gemm_phase<pg8::EpiRes, true>(F.lds, g, S, E);
            GRID_BAR();
        }
        for (int rp = 0; rp < REP_THIN; ++rp)
        if (IN(7)) { }
        for (int rp = 0; rp < REP_P8; ++rp)
        if (IN(8)) {
            pg8::Gemm g{P_XN, P_WFI, M, NFI, D, D, D}; pg8::StaticOrder S; S.init(M, NFI, F.G, F.bid); S.wgm = 8;
            pg8::EpiSwiGLU E{P_H, DFF, P_RS2 + (size_t)l * M};
            pg8::gemm_phase<pg8::EpiSwiGLU, true>(F.lds, g, S, E);
            GRID_BAR();
        }
        if (IN(9)) {
            pg8::Gemm g{P_H, P_WFO, M, D, DFF, DFF, DFF}; pg8::StaticOrder S; S.init(M, D, F.G, F.bid);
            pg8::EpiRes E{P_XN, (l + 1 < DEPTH) ? (float*)nullptr : P_out, D, P_RS1 + (size_t)(l + 1 < DEPTH ? l + 1 : 0) * M, (l + 1 < DEPTH) ? P_XB8 : (unsigned char*)nullptr};
            pg8::gemm_phase<pg8::EpiRes, true>(F.lds, g, S, E);
            GRID_BAR();
        }
    }
#undef IN
#undef GRID_BAR
}

extern "C" void kernel_launch(void* const* d_in, const int* in_sizes, int n_in, void* d_out, int out_size, void* d_ws, size_t ws_size, hipStream_t stream) {
    static int grid = 0;
    if (grid == 0) {
        if (n_in != 18 || out_size != M * D || ws_size < WS_END) { fprintf(stderr, "kernel_launch: unexpected shapes (n_in %d, out %d, ws %zu < %zu)\n", n_in, out_size, ws_size, (size_t)WS_END); grid = -1; return; }
        int dev = 0, cus = 0, per_cu = 0;
        if (hipGetDevice(&dev) != hipSuccess || hipDeviceGetAttribute(&cus, hipDeviceAttributeMultiprocessorCount, dev) != hipSuccess) { grid = -1; return; }
        if (hipFuncSetAttribute((const void*)mega_fwd, hipFuncAttributeMaxDynamicSharedMemorySize, LDS_BYTES) != hipSuccess) { fprintf(stderr, "kernel_launch: hipFuncSetAttribute failed\n"); grid = -1; return; }
        if (hipOccupancyMaxActiveBlocksPerMultiprocessor(&per_cu, (const void*)mega_fwd, NT, LDS_BYTES) != hipSuccess || per_cu < 1) { fprintf(stderr, "kernel_launch: occupancy query says %d\n", per_cu); }
        (void)hipGetLastError();
        grid = cus;
    }
    if (grid < 0) return;
    (void)hipMemsetAsync((char*)d_ws + WS_CTL, 0, CTL_ZERO_BYTES, stream);
    Args a{};
    for (int i = 0; i < 18; ++i) a.in[i] = (const float*)d_in[i];
    a.out = (float*)d_out; a.ws = (unsigned char*)d_ws;
#if MK_MULTI
    for (int l = 0; l < DEPTH; ++l)
        for (int p = 0; p < NPH; ++p) { a.l_lo = l; a.l_hi = l + 1; a.ph_lo = p; a.ph_hi = p + 1; hipLaunchKernelGGL(mega_fwd, dim3(grid), dim3(NT), LDS_BYTES, stream, a); }
#else
    a.l_lo = 0; a.l_hi = DEPTH; a.ph_lo = 0; a.ph_hi = NPH;
    hipLaunchKernelGGL(mega_fwd, dim3(grid), dim3(NT), LDS_BYTES, stream, a);
#endif
}
```

```cpp
#include <hip/hip_runtime.h>
#include <cstdio>
#include <cstdint>

#ifndef MK_MULTI
#define MK_MULTI 0
#endif

#define LAS __attribute__((address_space(3)))
#define GAS __attribute__((address_space(1)))
typedef unsigned short bf16_t;
typedef short bf16x8 __attribute__((ext_vector_type(8)));
typedef short s16x4 __attribute__((ext_vector_type(4)));
typedef float f32x4 __attribute__((ext_vector_type(4)));
typedef float f32x2 __attribute__((ext_vector_type(2)));
typedef unsigned u32x4 __attribute__((ext_vector_type(4)));
typedef unsigned u32x2 __attribute__((ext_vector_type(2)));

constexpr int D = 2048, BATCH = 8, SEQ = 4096, DEPTH = 4, M = BATCH * SEQ;
constexpr int NZ = 14080;
constexpr int ZQ = 0, ZK = 1536, ZV = 3072, ZBQ = 4608, ZBK = 4992, ZBV = 5376, ZCU = 6144, ZCV = 6912, ZGA = 7680, ZGB = 9728, ZGC = 11776, ZGL = 13824;
constexpr int DIN = 13840, DFF = 5632, NFI = 2 * DFF;
constexpr int GLA_DK = 96, GLA_DV = 192, NCHK = SEQ / 64;
constexpr float EPS = 1e-6f;
constexpr int NT = 512, NWAVES = 8;

constexpr size_t al256(size_t x) { return (x + 255) & ~(size_t)255; }
constexpr size_t WS_CTL = 0, CTL_ZERO_BYTES = 4u << 20;
typedef unsigned long long rs_t;
constexpr float RS_SCALE = 16777216.0f, RS_INV = 1.0f / 16777216.0f;
constexpr size_t WS_RS1 = 256u << 10;
constexpr size_t WS_RS2 = WS_RS1 + (size_t)DEPTH * M * 8;
static_assert(WS_RS2 + (size_t)DEPTH * M * 8 <= CTL_ZERO_BYTES, "RS buffers inside the zeroed region");
constexpr int N8 = 10752, NB = 3328;
constexpr float W8_SCALE = 256.0f, W8_INV = 1.0f / 256.0f;
constexpr size_t WS_WIN = CTL_ZERO_BYTES;
constexpr size_t WS_W8 = WS_WIN + (size_t)NB * D * 2;
constexpr size_t WS_XB8 = WS_W8 + (size_t)N8 * D;
constexpr size_t WS_WBR = WS_XB8 + (size_t)M * D;
constexpr size_t WS_WO = WS_WBR + (size_t)D * D * 2;
constexpr size_t WS_WFI = WS_WO + (size_t)D * D * 2;
constexpr size_t WS_WFO = WS_WFI + (size_t)NFI * D * 2;
constexpr size_t WS_XN = WS_WFO + (size_t)D * DFF * 2;
constexpr size_t WS_Y = WS_XN + (size_t)M * D * 2;
constexpr size_t WS_OMIX = WS_Y + (size_t)M * D * 2;
constexpr size_t WS_Z = WS_OMIX + (size_t)M * D * 2;
constexpr size_t WS_SP = WS_Z + (size_t)M * NZ * 2;
constexpr size_t WS_QT = WS_SP + (size_t)BATCH * NCHK * 4 * GLA_DV * GLA_DK * 2;
constexpr size_t WS_KT = WS_QT + (size_t)M * 384 * 2;
constexpr size_t WS_DL = WS_KT + (size_t)M * 384 * 2;
constexpr size_t WS_LSE = WS_DL + (size_t)BATCH * NCHK * 4 * GLA_DK * 4;
constexpr size_t WS_END = WS_LSE + (size_t)3 * M * 4 * 4;
constexpr size_t OUT_SL = 0;
constexpr size_t OUT_AO = OUT_SL + (size_t)BATCH * NCHK * 4 * GLA_DV * GLA_DK * 2;
static_assert(OUT_AO + (size_t)3 * M * 512 * 2 <= (size_t)M * D * 4, "scratch fits in d_out");
constexpr int CW_BAR = 4096;

typedef __bf16 bf16x2_t __attribute__((ext_vector_type(2)));
__device__ __forceinline__ unsigned cvt_pk_bf16(float lo, float hi) { const f32x2 v = {lo, hi}; return __builtin_bit_cast(unsigned, __builtin_convertvector(v, bf16x2_t)); }
__device__ __forceinline__ float bflo(unsigned w) { return __uint_as_float(w << 16); }
__device__ __forceinline__ float bfhi(unsigned w) { return __uint_as_float(w & 0xffff0000u); }
__device__ __forceinline__ float fast_rcp(float x) { return __builtin_amdgcn_rcpf(x); }
__device__ __forceinline__ float sigmoidf_(float x) { return fast_rcp(1.0f + __expf(-x)); }
__device__ __forceinline__ float gelu_tanh(float x) { const float u = 0.7978845608028654f * (x + 0.044715f * x * x * x); return x * fast_rcp(1.0f + __expf(-2.0f * u)); }
__device__ __forceinline__ float wave_sum(float v) {
#pragma unroll
    for (int o = 1; o < 64; o <<= 1) v += __shfl_xor(v, o);
    return v;
}
__device__ __forceinline__ int opq_tid() { int t = threadIdx.x; asm volatile("" : "+v"(t)); return t; }
#define LDS_WAIT() asm volatile("s_waitcnt lgkmcnt(0)" ::: "memory")
#define WG_SYNC() asm volatile("s_waitcnt lgkmcnt(0)\n\ts_barrier" ::: "memory")
#define VM_WAIT() asm volatile("s_waitcnt vmcnt(0)" ::: "memory")

namespace pg8 {
constexpr int BM = 256, BK = 64, HALF = 128, HTB = HALF * BK * 2, STAGE_BYTES = 8 * HTB, NXCD = 8;
typedef int v4i_t __attribute__((ext_vector_type(4)));
typedef int v8i_t __attribute__((ext_vector_type(8)));
__host__ __device__ __forceinline__ int lds_byte(int r, int c) { const int st = (r >> 4) * 2 + (c >> 5), rr = r & 15, cc = c & 31, ob = rr * 64 + cc * 2; return st * 1024 + (ob ^ (((ob >> 9) & 1) << 5)); }
__host__ __device__ __forceinline__ void stage_rc(int b, int& R, int& C) { const int st = b / 1024, sb = b % 1024, swz = sb ^ (((sb >> 9) & 1) << 5); R = (st >> 1) * 16 + swz / 64; C = (st & 1) * 32 + (swz % 64) / 2; }
__host__ __device__ __forceinline__ void stage_rc8(int b, int& R, int& Cb) { const int rb = b >> 11, within = b & 2047, slot = within >> 5, half = (within >> 4) & 1, fq = slot >> 4, fr = slot & 15, k = half ^ (fq & 1); R = 16 * rb + fr; Cb = 64 * k + 16 * fq; }
__host__ __device__ __forceinline__ int perm32(int rho) { const int n = rho >> 4, i = rho & 15; return 8 * (i >> 2) + 4 * n + (i & 3); }
struct Unit { int pm, pn, br; };
struct Gemm { const void* A; const void* Bt; int M, N, K, lda, ldb; };
struct StaticOrder {
    int nM, nN, nwg, G, c, full, c0, extra, nbr, wgm;
    __host__ __device__ void init(int M_, int N_, int G_, int c_) { nM = M_ / BM; nN = N_ / BM; nwg = nM * nN; G = G_; c = c_; full = 0x3fffffff; c0 = 0; extra = 0; nbr = 1; wgm = 4; }
    __host__ __device__ bool next(int i, Unit& u) const {
        long L; u.br = 0;
        if (nbr > 1) { u.br = i % nbr; i /= nbr; }
        if (i < full) L = (long)i * G + c; else { const int j = i - full; if (c < c0 || j >= extra) return false; L = (long)full * G + (long)(c - c0) * extra + j; }
        if (L >= nwg) return false;
        int wgid = (int)L; const int xcd = wgid % NXCD; { const int q = nwg / NXCD, r = nwg % NXCD, off = wgid / NXCD; wgid = (xcd < r ? xcd * (q + 1) : r * (q + 1) + (xcd - r) * q) + off; }
        const int nig = wgm * nN, gid = wgid / nig, fm = gid * wgm, gsz = (nM - fm) < wgm ? (nM - fm) : wgm;
        u.pm = fm + ((wgid % nig) % gsz); u.pn = ((wgid % nig) / gsz + ((nwg % (NXCD * nig)) == 0 ? xcd * (nN / NXCD) : 0)) % nN; return true;
    }
};
struct EpiStoreBf16 {
    static constexpr bool PERM = true, ROWSCALE = true, SWAP = true;
    bf16_t* O; int ldc; const rs_t* rs; int split, off_lo, off_hi; float mul;
    __device__ __forceinline__ void operator()(const f32x4 (&acc)[2][2][4][2], const Unit& u, int wr, int wc, int fr, int fq, const LAS float* rsl) const {
        const int row0 = u.pm * BM + wr * 64 + 4 * fq, col0 = (u.pn < split ? off_lo + u.pn * BM : off_hi + (u.pn - split) * BM) + wc * 64 + 4 * fr;
#pragma unroll
        for (int ai = 0; ai < 2; ++ai)
#pragma unroll
            for (int m = 0; m < 4; ++m) { bf16_t* rowp = O + (size_t)(row0 + ai * HALF + m * 16) * ldc + col0;
                const f32x4 sc = *(const LAS f32x4*)(rsl + wr * 64 + 4 * fq + ai * HALF + m * 16) * mul;
#pragma unroll
                for (int i = 0; i < 4; ++i) { u32x2 w; w.x = cvt_pk_bf16(acc[ai][0][m][0][i] * sc[i], acc[ai][0][m][1][i] * sc[i]); w.y = cvt_pk_bf16(acc[ai][1][m][0][i] * sc[i], acc[ai][1][m][1][i] * sc[i]);
                    __builtin_nontemporal_store(w, (u32x2*)(rowp + (size_t)i * ldc)); } }
    }
};
struct EpiGate {
    static constexpr bool PERM = true, ROWSCALE = false, SWAP = false;
    bf16_t* Y; const bf16_t* G; int ldy, ldg;
    static __device__ __forceinline__ float e_neg(float g) { return __expf(-__builtin_amdgcn_fmed3f(g, -30.0f, 30.0f)); }
    __device__ __forceinline__ void operator()(f32x4 (&acc)[2][2][4][2], const Unit& u, int wr, int wc, int fr, int fq, const LAS float*) const {
        const int row0 = u.pm * BM + wr * 64 + fr, col0 = u.pn * BM + wc * 32 + 8 * fq; const bf16_t* Gb = G + u.br * D;
        if (u.br < 2) {
#pragma unroll
            for (int ai = 0; ai < 2; ++ai) {
                u32x4 g0[4][2], g1[4][2];
#pragma unroll
                for (int m = 0; m < 4; ++m) { const size_t row = (size_t)(row0 + ai * HALF + m * 16);
#pragma unroll
                    for (int bj = 0; bj < 2; ++bj) { g0[m][bj] = *(const u32x4*)(Gb + row * ldg + col0 + bj * HALF); g1[m][bj] = *(const u32x4*)(Gb + D + row * ldg + col0 + bj * HALF); } }
#pragma unroll
                for (int m = 0; m < 4; ++m)
#pragma unroll
                    for (int bj = 0; bj < 2; ++bj) { const u32x4 a = g0[m][bj], b = g1[m][bj];
                        const unsigned aw[4] = {a.x, a.y, a.z, a.w}, bw[4] = {b.x, b.y, b.z, b.w};
#pragma unroll
                        for (int q = 0; q < 4; ++q) {
                            const float rl = (1.0f + e_neg(bflo(bw[q]))) * fast_rcp(1.0f + e_neg(bflo(aw[q]))), rh = (1.0f + e_neg(bfhi(bw[q]))) * fast_rcp(1.0f + e_neg(bfhi(aw[q])));
                            acc[ai][bj][m][q >> 1][2 * (q & 1)] *= rl; acc[ai][bj][m][q >> 1][2 * (q & 1) + 1] *= rh; } }
                asm volatile("" ::: "memory"); }
        } else {
#pragma unroll
            for (int ai = 0; ai < 2; ++ai) {
                u32x4 g[4][2];
#pragma unroll
                for (int m = 0; m < 4; ++m) { const size_t row = (size_t)(row0 + ai * HALF + m * 16);
#pragma unroll
                    for (int bj = 0; bj < 2; ++bj) g[m][bj] = *(const u32x4*)(Gb + row * ldg + col0 + bj * HALF); }
#pragma unroll
                for (int m = 0; m < 4; ++m) { const size_t row = (size_t)(row0 + ai * HALF + m * 16);
#pragma unroll
                    for (int bj = 0; bj < 2; ++bj) { const f32x4 v0 = acc[ai][bj][m][0], v1 = acc[ai][bj][m][1]; const u32x4 gg = g[m][bj];
                        float o[8];
                        o[0] = v0[0] * fast_rcp(1.0f + e_neg(bflo(gg.x))); o[1] = v0[1] * fast_rcp(1.0f + e_neg(bfhi(gg.x)));
                        o[2] = v0[2] * fast_rcp(1.0f + e_neg(bflo(gg.y))); o[3] = v0[3] * fast_rcp(1.0f + e_neg(bfhi(gg.y)));
                        o[4] = v1[0] * fast_rcp(1.0f + e_neg(bflo(gg.z))); o[5] = v1[1] * fast_rcp(1.0f + e_neg(bfhi(gg.z)));
                        o[6] = v1[2] * fast_rcp(1.0f + e_neg(bflo(gg.w))); o[7] = v1[3] * fast_rcp(1.0f + e_neg(bfhi(gg.w)));
                        u32x4 w; w.x = cvt_pk_bf16(o[0], o[1]); w.y = cvt_pk_bf16(o[2], o[3]); w.z = cvt_pk_bf16(o[4], o[5]); w.w = cvt_pk_bf16(o[6], o[7]);
                        *(u32x4*)(Y + row * ldy + col0 + bj * HALF) = w; } }
                asm volatile("" ::: "memory"); }
        }
    }
};
struct EpiRes {
    static constexpr bool PERM = true, ROWSCALE = false, SWAP = false;
    bf16_t* xb; float* outf; int ldc; rs_t* rs; unsigned char* xb8;
    __device__ __forceinline__ void operator()(const f32x4 (&acc)[2][2][4][2], const Unit& u, int wr, int wc, int fr, int fq, const LAS float*) const {
        const int row0 = u.pm * BM + wr * 64 + fr, col0 = u.pn * BM + wc * 32 + 8 * fq;
#pragma unroll
        for (int ai = 0; ai < 2; ++ai) {
            u32x4 bs[4][2];
#pragma unroll
            for (int m = 0; m < 4; ++m) { const size_t off = (size_t)(row0 + ai * HALF + m * 16) * ldc + col0;
#pragma unroll
                for (int bj = 0; bj < 2; ++bj) bs[m][bj] = *(const u32x4*)(xb + off + bj * HALF); }
#pragma unroll
            for (int m = 0; m < 4; ++m) { const size_t off = (size_t)(row0 + ai * HALF + m * 16) * ldc + col0; float ss = 0.f;
#pragma unroll
                for (int bj = 0; bj < 2; ++bj) { const u32x4 b4 = bs[m][bj];
                    const f32x4 o0 = (f32x4){bflo(b4.x), bfhi(b4.x), bflo(b4.y), bfhi(b4.y)} + acc[ai][bj][m][0], o1 = (f32x4){bflo(b4.z), bfhi(b4.z), bflo(b4.w), bfhi(b4.w)} + acc[ai][bj][m][1];
                    if (outf) { *(f32x4*)(outf + off + bj * HALF) = o0; *(f32x4*)(outf + off + bj * HALF + 4) = o1; }
                    else { u32x4 w; w.x = cvt_pk_bf16(o0[0], o0[1]); w.y = cvt_pk_bf16(o0[2], o0[3]); w.z = cvt_pk_bf16(o1[0], o1[1]); w.w = cvt_pk_bf16(o1[2], o1[3]); *(u32x4*)(xb + off + bj * HALF) = w;
                        ss += ((o0[0] * o0[0] + o0[1] * o0[1]) + (o0[2] * o0[2] + o0[3] * o0[3])) + ((o1[0] * o1[0] + o1[1] * o1[1]) + (o1[2] * o1[2] + o1[3] * o1[3])); }
                    if (xb8) { u32x2 q; q.x = 0u; q.y = 0u; q.x = __builtin_amdgcn_cvt_pk_fp8_f32(o0[0], o0[1], q.x, false); q.x = __builtin_amdgcn_cvt_pk_fp8_f32(o0[2], o0[3], q.x, true);
                        q.y = __builtin_amdgcn_cvt_pk_fp8_f32(o1[0], o1[1], q.y, false); q.y = __builtin_amdgcn_cvt_pk_fp8_f32(o1[2], o1[3], q.y, true); *(u32x2*)(xb8 + off + bj * HALF) = q; } }
                if (!outf) { ss += __shfl_xor(ss, 16); ss += __shfl_xor(ss, 32); if (fq == 0) __hip_atomic_fetch_add(rs + row0 + ai * HALF + m * 16, (rs_t)(ss * RS_SCALE + 0.5f), __ATOMIC_RELAXED, __HIP_MEMORY_SCOPE_AGENT); } }
            asm volatile("" ::: "memory"); }
    }
};
struct EpiSwiGLU {
    static constexpr bool PERM = true, ROWSCALE = true, SWAP = false;
    bf16_t* H; int ldh; const rs_t* rs;
    __device__ __forceinline__ void operator()(const f32x4 (&acc)[2][2][4][2], const Unit& u, int wr, int wc, int fr, int fq, const LAS float* rsl) const {
        const int row0 = u.pm * BM + wr * 64 + fr, col0 = u.pn * HALF + wc * 32 + 8 * fq;
#pragma unroll
        for (int ai = 0; ai < 2; ++ai)
#pragma unroll
            for (int m = 0; m < 4; ++m) { const float sc = rsl[wr * 64 + fr + ai * HALF + m * 16];
                const f32x4 g0 = acc[ai][0][m][0] * sc, g1 = acc[ai][0][m][1] * sc, u0 = acc[ai][1][m][0] * sc, u1 = acc[ai][1][m][1] * sc;
                float o[8];
#pragma unroll
                for (int j = 0; j < 4; ++j) { o[j] = g0[j] * sigmoidf_(g0[j]) * u0[j]; o[4 + j] = g1[j] * sigmoidf_(g1[j]) * u1[j]; }
                u32x4 w; w.x = cvt_pk_bf16(o[0], o[1]); w.y = cvt_pk_bf16(o[2], o[3]); w.z = cvt_pk_bf16(o[4], o[5]); w.w = cvt_pk_bf16(o[6], o[7]);
                __builtin_nontemporal_store(w, (u32x4*)(H + (size_t)(row0 + ai * HALF + m * 16) * ldh + col0)); }
    }
};

template <class Epi, bool ALIGN_EPI, bool FP8 = false, bool BR3 = false>
__device__ __forceinline__ void gemm_phase(LAS unsigned char* lds, const Gemm g, const StaticOrder& S, const Epi& E) {
    const int tid = opq_tid(), wid = __builtin_amdgcn_readfirstlane(tid >> 6), lane = tid & 63, wr = wid >> 2, wc = wid & 3, fr = lane & 15, fq = lane >> 4;
    constexpr int ESZ = FP8 ? 1 : 2;
    const int K = g.K; int nt = K * ESZ / (BK * 2);
#define PG8_KOFF(u) (BR3 ? ((u).br == 0 ? 0 : ((u).br == 1 ? 1024 : 2560)) : 0)
#define PG8_NT(u) (BR3 ? ((u).br == 0 ? 8 : 12) : nt)
    unsigned voffA[2], voffB[2];
#pragma unroll
    for (int i = 0; i < 2; ++i) { int R, C; if constexpr (FP8) stage_rc8(tid * 16 + i * 8192, R, C); else { stage_rc(tid * 16 + i * 8192, R, C); C *= 2; }
        const int Rb = Epi::SWAP ? (64 * (R >> 5) + 4 * (R & 15) + ((R >> 4) & 1)) : (Epi::PERM ? ((R & ~31) + perm32(R & 31)) : R);
        voffA[i] = (unsigned)(R * g.lda * ESZ + C); voffB[i] = (unsigned)(Rb * g.ldb * ESZ + C); }
    const size_t kstep = (size_t)(BK * 2);
    const size_t hstepA = (size_t)HALF * g.lda * ESZ, hstepB = (size_t)(Epi::SWAP ? 2 : HALF) * g.ldb * ESZ;
    const size_t tstepA = 2 * hstepA, tstepB = (size_t)BM * g.ldb * ESZ;
    const unsigned ldsw = (unsigned)wid * 1024u;
    const int aoff = FP8 ? wr * 8192 + lane * 32 : lds_byte(wr * 64 + fr, fq * 8), boff = FP8 ? wc * 4096 + lane * 32 : lds_byte(wc * 32 + fr, fq * 8);
    LAS float* rsl = (LAS float*)(lds + STAGE_BYTES);
#define PG8_SA(b, h) (((b) * 2 + (h)) * HTB)
#define PG8_SB(b, h) ((4 + (b) * 2 + (h)) * HTB)
#define PG8_STAGE(bufoff, gbase, voff) do { _Pragma("unroll") for (int _i = 0; _i < 2; ++_i) \
        __builtin_amdgcn_global_load_lds((const unsigned*)((const char*)(gbase) + (voff)[_i]), (LAS unsigned*)(lds + (bufoff) + ldsw + _i * 8192), 16, 0, 0); } while (0)
#define PG8_LDA(dst, b, h) do { _Pragma("unroll") for (int m = 0; m < 4; ++m) { if constexpr (FP8) { const v4i_t lo_ = *(const LAS v4i_t*)(lds + PG8_SA(b, h) + aoff + m * 2048), hi_ = *(const LAS v4i_t*)(lds + PG8_SA(b, h) + aoff + m * 2048 + 16); dst##8[m] = __builtin_shufflevector(lo_, hi_, 0, 1, 2, 3, 4, 5, 6, 7); } \
        else { _Pragma("unroll") for (int k = 0; k < 2; ++k) dst[m][k] = *(const LAS bf16x8*)(lds + PG8_SA(b, h) + aoff + m * 2048 + k * 1024); } } } while (0)
#define PG8_LDB(dst, b, h) do { _Pragma("unroll") for (int n = 0; n < 2; ++n) { if constexpr (FP8) { const v4i_t lo_ = *(const LAS v4i_t*)(lds + PG8_SB(b, h) + boff + n * 2048), hi_ = *(const LAS v4i_t*)(lds + PG8_SB(b, h) + boff + n * 2048 + 16); dst##8[n] = __builtin_shufflevector(lo_, hi_, 0, 1, 2, 3, 4, 5, 6, 7); } \
        else { _Pragma("unroll") for (int k = 0; k < 2; ++k) dst[n][k] = *(const LAS bf16x8*)(lds + PG8_SB(b, h) + boff + n * 2048 + k * 1024); } } } while (0)
#define PG8_MMA(ai, bj, At, Bt) do { __builtin_amdgcn_s_setprio(1); _Pragma("unroll") for (int m = 0; m < 4; ++m) _Pragma("unroll") for (int n = 0; n < 2; ++n) { \
        if constexpr (FP8) { if constexpr (Epi::SWAP) asm volatile("v_mfma_f32_16x16x128_f8f6f4 %0, %1, %2, %0" : "+v"(acc[ai][bj][m][n]) : "v"(At##8[m]), "v"(Bt##8[n])); \
            else asm volatile("v_mfma_f32_16x16x128_f8f6f4 %0, %1, %2, %0" : "+v"(acc[ai][bj][m][n]) : "v"(Bt##8[n]), "v"(At##8[m])); }   \
        else { _Pragma("unroll") for (int k = 0; k < 2; ++k) acc[ai][bj][m][n] = Epi::SWAP ? __builtin_amdgcn_mfma_f32_16x16x32_bf16(At[m][k], Bt[n][k], acc[ai][bj][m][n], 0, 0, 0) : __builtin_amdgcn_mfma_f32_16x16x32_bf16(Bt[n][k], At[m][k], acc[ai][bj][m][n], 0, 0, 0); } } __builtin_amdgcn_s_setprio(0); } while (0)
#define PG8_WAIT_V(n) asm volatile("s_waitcnt vmcnt(" #n ")" ::: "memory")
#define PG8_WAIT_L(n) asm volatile("s_waitcnt lgkmcnt(" #n ")" ::: "memory")
#define PG8_BAR __builtin_amdgcn_s_barrier()
#define PG8_SCHED __builtin_amdgcn_sched_barrier(0)
    Unit cur, nxt; int ui = 0;
    if (!S.next(0, cur)) return;
    f32x4 acc[2][2][4][2];
#pragma unroll
    for (int a = 0; a < 2; ++a)
#pragma unroll
        for (int b = 0; b < 2; ++b)
#pragma unroll
            for (int m = 0; m < 4; ++m)
#pragma unroll
                for (int n = 0; n < 2; ++n) acc[a][b][m][n] = (f32x4){0.f, 0.f, 0.f, 0.f};
    bf16x8 At[4][2], B0[2][2], B1[2][2];
    v8i_t At8[4], B08[2], B18[2];
    const char* cA = (const char*)g.A + (size_t)cur.pm * tstepA + PG8_KOFF(cur); const char* cB = (const char*)g.Bt + (size_t)cur.pn * tstepB + PG8_KOFF(cur);
    PG8_STAGE(PG8_SB(0, 0), cB, voffB); PG8_STAGE(PG8_SB(0, 1), cB + hstepB, voffB); PG8_STAGE(PG8_SA(0, 0), cA, voffA); PG8_STAGE(PG8_SA(0, 1), cA + hstepA, voffA);
    if (wr == 1) PG8_BAR;
    PG8_WAIT_V(2); PG8_BAR;
    PG8_STAGE(PG8_SB(1, 0), cB + kstep, voffB); PG8_STAGE(PG8_SA(1, 0), cA + kstep, voffA); PG8_STAGE(PG8_SB(1, 1), cB + hstepB + kstep, voffB);
    PG8_WAIT_V(6); PG8_BAR;
    for (;;) {
        const bool has_next = S.next(ui + 1, nxt);
        rs_t rv = 0; if constexpr (Epi::ROWSCALE) { const rs_t* rp = E.rs + cur.pm * BM + (tid & 255); asm volatile("global_load_dwordx2 %0, %1, off" : "=v"(rv) : "v"(rp) : "memory"); }
        const char* nA = has_next ? (const char*)g.A + (size_t)nxt.pm * tstepA + PG8_KOFF(nxt) : cA; const char* nB = has_next ? (const char*)g.Bt + (size_t)nxt.pn * tstepB + PG8_KOFF(nxt) : cB;
        nt = PG8_NT(cur);
        for (int t = 0; t < nt; t += 2) {
            const bool last = (t == nt - 2);
            const char* a1 = cA + (size_t)(t + 1) * kstep;
            const char* a2 = last ? nA : cA + (size_t)(t + 2) * kstep; const char* b2 = last ? nB : cB + (size_t)(t + 2) * kstep;
            const char* a3 = a2 + kstep; const char* b3 = b2 + kstep;
            PG8_LDB(B0, 0, 0); PG8_LDB(B1, 0, 1); PG8_SCHED; PG8_LDA(At, 0, 0); PG8_STAGE(PG8_SA(1, 1), a1 + hstepA, voffA);
            PG8_WAIT_V(8); PG8_WAIT_L(0); PG8_BAR; PG8_MMA(0, 0, At, B0); PG8_MMA(0, 1, At, B1); PG8_BAR; PG8_SCHED;
            PG8_LDA(At, 0, 1); PG8_STAGE(PG8_SB(0, 0), b2, voffB); PG8_STAGE(PG8_SB(0, 1), b2 + hstepB, voffB); PG8_STAGE(PG8_SA(0, 0), a2, voffA);
            PG8_WAIT_V(8); PG8_WAIT_L(0); PG8_BAR; PG8_MMA(1, 0, At, B0); PG8_MMA(1, 1, At, B1); PG8_BAR; PG8_SCHED;
            PG8_LDB(B0, 1, 0); PG8_LDB(B1, 1, 1); PG8_SCHED; PG8_LDA(At, 1, 0); PG8_STAGE(PG8_SA(0, 1), a2 + hstepA, voffA);
            PG8_WAIT_V(8); PG8_WAIT_L(0); PG8_BAR; PG8_MMA(0, 0, At, B0); PG8_MMA(0, 1, At, B1); PG8_BAR; PG8_SCHED;
            PG8_LDA(At, 1, 1); PG8_STAGE(PG8_SB(1, 0), b3, voffB); PG8_STAGE(PG8_SB(1, 1), b3 + hstepB, voffB); PG8_STAGE(PG8_SA(1, 0), a3, voffA);
            PG8_WAIT_V(8); PG8_WAIT_L(0); PG8_BAR; PG8_MMA(1, 0, At, B0); PG8_MMA(1, 1, At, B1); PG8_BAR; PG8_SCHED;
        }
        if constexpr (FP8) asm volatile("s_nop 7\n\ts_nop 7\n\ts_nop 7" ::: "memory");
        if constexpr (ALIGN_EPI) { if (wr == 0) PG8_BAR; }
        if constexpr (Epi::ROWSCALE) {
            static_assert(ALIGN_EPI, "row-scale table needs the aligned epilogue");
            asm volatile("s_waitcnt vmcnt(0)" : "+v"(rv) :: "memory");
            if (tid < 256) rsl[tid] = 1.0f / sqrtf((float)rv * (RS_INV / D) + EPS);
            PG8_WAIT_L(0); PG8_BAR; }
        E(acc, cur, wr, wc, fr, fq, rsl);
        if (!has_next) break;
        if (!BR3 || cur.br == 2) {
#pragma unroll
        for (int a = 0; a < 2; ++a)
#pragma unroll
            for (int b = 0; b < 2; ++b)
#pragma unroll
                for (int m = 0; m < 4; ++m)
#pragma unroll
                    for (int n = 0; n < 2; ++n) acc[a][b][m][n] = (f32x4){0.f, 0.f, 0.f, 0.f};
        }
        cur = nxt; cA = nA; cB = nB; ++ui;
        if constexpr (ALIGN_EPI) { if (wr == 1) PG8_BAR; }
    }
    PG8_WAIT_V(0);
    if constexpr (!ALIGN_EPI) { if (wr == 0) PG8_BAR; }
    PG8_BAR;
#undef PG8_SA
#undef PG8_SB
#undef PG8_STAGE
#undef PG8_LDA
#undef PG8_LDB
#undef PG8_MMA
#undef PG8_KOFF
#undef PG8_NT
#undef PG8_WAIT_V
#undef PG8_WAIT_L
#undef PG8_BAR
#undef PG8_SCHED
}
}

#define XB_TMO      128
#define XB_XCNT(j)  (256  + 64 * (j))
#define XB_XSUB(j)  (1280 + 64 * (j))
#define XB_XGEN(j)  (2304 + 64 * (j))
#define XB_TOP      3328
#define XB_TOPGEN   3392
#define XCD_BAR_WORDS 3456
#define XB_SPIN_CAP (1u << 18)
__device__ __forceinline__ unsigned xb_ld(unsigned* p)              { return __hip_atomic_load(p, __ATOMIC_RELAXED, __HIP_MEMORY_SCOPE_AGENT); }
__device__ __forceinline__ unsigned xb_add(unsigned* p, unsigned v) { return __hip_atomic_fetch_add(p, v, __ATOMIC_RELAXED, __HIP_MEMORY_SCOPE_AGENT); }
__device__ __forceinline__ unsigned xb_xcc_id() { return (unsigned)__builtin_amdgcn_s_getreg((3 << 11) | 20) & 0xFu; }
#define XB_SPIN(cond, bar) do { unsigned _sp = 0; while (cond) { __builtin_amdgcn_s_sleep(1); \
    if ((++_sp & 255u) == 0u) { if (xb_ld(&(bar)[XB_TMO])) break; if (_sp > XB_SPIN_CAP) { atomicAdd(&(bar)[XB_TMO], 1u); break; } } } } while (0)
struct XcdBarrier { unsigned* bar; unsigned x; volatile LAS unsigned* st; };
__device__ __forceinline__ XcdBarrier xcd_barrier_post(unsigned* bar, volatile LAS unsigned* st) {
    XcdBarrier b; b.bar = bar; b.x = xb_xcc_id(); b.st = st;
    if (threadIdx.x == 0) (void)xb_add(&bar[XB_XCNT(b.x)], 1u);
    return b;
}
__device__ __forceinline__ void xcd_barrier_complete(unsigned* bar, unsigned x, unsigned& nloc, unsigned& nx) {
    const unsigned G = gridDim.x * gridDim.y * gridDim.z;
    unsigned sum, cnt, mine, sp = 0u;
    for (;;) {
        sum = 0u; cnt = 0u; mine = 0u;
#pragma unroll
        for (unsigned j = 0; j < 16; ++j) { const unsigned c = xb_ld(&bar[XB_XCNT(j)]); sum += c; cnt += (c > 0u) ? 1u : 0u; mine = (j == x) ? c : mine; }
        if (sum == G) break;
        __builtin_amdgcn_s_sleep(1);
        if ((++sp & 255u) == 0u) { if (xb_ld(&bar[XB_TMO])) break; if (sp > XB_SPIN_CAP) { atomicAdd(&bar[XB_TMO], 1u); break; } }
    }
    nloc = mine > 0u ? mine : 1u; nx = cnt > 0u ? cnt : 1u;
}
__device__ __forceinline__ void xcd_barrier(const XcdBarrier& b) {
    asm volatile("s_waitcnt vmcnt(0)" ::: "memory");
    __syncthreads();
    if (threadIdx.x == 0) {
        unsigned* bar = b.bar;
        __builtin_amdgcn_s_waitcnt(0);
        unsigned nloc = b.st[0], nx = b.st[1];
        if (nloc == 0u) { xcd_barrier_complete(bar, b.x, nloc, nx); b.st[0] = nloc; b.st[1] = nx; }
        const unsigned old = xb_add(&bar[XB_XSUB(b.x)], 1u);
        const unsigned gen = old / nloc;
        if (old + 1u == (gen + 1u) * nloc) {
            __builtin_amdgcn_fence(__ATOMIC_RELEASE, "agent");
            asm volatile("s_waitcnt vmcnt(0)" ::: "memory");
            const unsigned og = xb_add(&bar[XB_TOP], 1u);
            const unsigned tg = og / nx;
            if (og + 1u == (tg + 1u) * nx) xb_add(&bar[XB_TOPGEN], 1u);
            else XB_SPIN(xb_ld(&bar[XB_TOPGEN]) == tg, bar);
            __builtin_amdgcn_fence(__ATOMIC_ACQUIRE, "agent");
            xb_add(&bar[XB_XGEN(b.x)], 1u);
            asm volatile("s_waitcnt vmcnt(0)" ::: "memory");
        } else {
            XB_SPIN(xb_ld(&bar[XB_XGEN(b.x)]) == gen, bar);
            __builtin_amdgcn_fence(__ATOMIC_ACQUIRE, "agent");
            asm volatile("s_waitcnt vmcnt(0)" ::: "memory");
        }
    }
    __syncthreads();
}

constexpr int RING_BYTES = 131072;
constexpr int LDS_MISC = RING_BYTES + 2048;
constexpr int LDS_BYTES = 147456;
struct Args {
    const float* in[18]; float* out; unsigned char* ws;
    int l_lo, l_hi, ph_lo, ph_hi;
};
struct Frame {
    LAS unsigned char* lds;
    int G, bid;
};
typedef const __attribute__((address_space(4))) Args* KArgsP;
__device__ __forceinline__ KArgsP kargs() { KArgsP p = (KArgsP)__builtin_amdgcn_kernarg_segment_ptr(); asm volatile("" : "+s"(p)); return p; }
#define A_IN(i) (kargs()->in[i])
#define A_WS(T, off) ((T*)(kargs()->ws + (off)))
#define A_OUT (kargs()->out)
#define P_x A_IN(0)
#define P_rel_bias A_IN(1)
#define P_norm1_g A_IN(2)
#define P_w_in A_IN(3)
#define P_q_norm_g A_IN(4)
#define P_k_norm_g A_IN(5)
#define P_gla_gate_up A_IN(6)
#define P_gla_gate_b A_IN(7)
#define P_gla_out_g A_IN(8)
#define P_sgu_ln_g A_IN(9)
#define P_sgu_ln_b A_IN(10)
#define P_sgu_w A_IN(11)
#define P_sgu_b A_IN(12)
#define P_w_branch A_IN(13)
#define P_w_out A_IN(14)
#define P_norm2_g A_IN(15)
#define P_w_ffn_in A_IN(16)
#define P_w_ffn_out A_IN(17)
#define P_WIN A_WS(bf16_t, WS_WIN)
#define P_W8 A_WS(unsigned char, WS_W8)
#define P_XB8 A_WS(unsigned char, WS_XB8)
#define P_WBR A_WS(bf16_t, WS_WBR)
#define P_WO A_WS(bf16_t, WS_WO)
#define P_WFI A_WS(bf16_t, WS_WFI)
#define P_WFO A_WS(bf16_t, WS_WFO)
#define P_XN A_WS(bf16_t, WS_XN)
#define P_Y A_WS(bf16_t, WS_Y)
#define P_OMIX A_WS(bf16_t, WS_OMIX)
#define P_Z A_WS(bf16_t, WS_Z)
#define P_H A_WS(bf16_t, WS_Z)
#define P_SP A_WS(bf16_t, WS_SP)
#define P_QT A_WS(bf16_t, WS_QT)
#define P_KT A_WS(bf16_t, WS_KT)
#define P_AO ((bf16_t*)((unsigned char*)A_OUT + OUT_AO))
#define P_SL ((bf16_t*)((unsigned char*)A_OUT + OUT_SL))
#define P_DL A_WS(float, WS_DL)
#define P_LSE A_WS(float, WS_LSE)
#define P_out A_OUT
#define P_RS1 A_WS(rs_t, WS_RS1)
#define P_RS2 A_WS(rs_t, WS_RS2)

template <bool FP8OUT, class SrcCol>
__device__ __forceinline__ void transpose_item(const float* W, int ldw, void* WTv, int K, LAS float* scr, int item, int nblk, int lane, const float* gain, SrcCol srccol) {
    const int kb = item / nblk, nb = item % nblk, k0 = 64 * kb, n0 = 32 * nb;
    const int nq = lane & 7, kr = lane >> 3, sc = srccol(n0 + 4 * nq);
    f32x4 v[8]; float gk[8];
#pragma unroll
    for (int i = 0; i < 8; ++i) { const int kk = 8 * i + kr; v[i] = sc >= 0 ? *(const f32x4*)(W + (size_t)(k0 + kk) * ldw + sc) : (f32x4){0.f, 0.f, 0.f, 0.f}; gk[i] = gain ? gain[k0 + kk] : 1.0f; }
#pragma unroll
    for (int i = 0; i < 8; ++i) { const int kk = 8 * i + kr; LAS float* d = scr + kk * 33 + 4 * nq; d[0] = v[i].x * gk[i]; d[1] = v[i].y * gk[i]; d[2] = v[i].z * gk[i]; d[3] = v[i].w * gk[i]; }
    LDS_WAIT(); asm volatile("" ::: "memory");
    const int c = lane & 7;
#pragma unroll
    for (int j = 0; j < 4; ++j) { const int n = (lane >> 3) + 8 * j; const LAS float* s = scr + (8 * c) * 33 + n;
        if constexpr (FP8OUT) { u32x2 o; o.x = 0u; o.y = 0u;
            o.x = __builtin_amdgcn_cvt_pk_fp8_f32(s[0 * 33] * W8_SCALE, s[1 * 33] * W8_SCALE, o.x, false); o.x = __builtin_amdgcn_cvt_pk_fp8_f32(s[2 * 33] * W8_SCALE, s[3 * 33] * W8_SCALE, o.x, true);
            o.y = __builtin_amdgcn_cvt_pk_fp8_f32(s[4 * 33] * W8_SCALE, s[5 * 33] * W8_SCALE, o.y, false); o.y = __builtin_amdgcn_cvt_pk_fp8_f32(s[6 * 33] * W8_SCALE, s[7 * 33] * W8_SCALE, o.y, true);
            *(u32x2*)((unsigned char*)WTv + (size_t)(n0 + n) * K + k0 + 8 * c) = o; }
        else { u32x4 o; o.x = cvt_pk_bf16(s[0 * 33], s[1 * 33]); o.y = cvt_pk_bf16(s[2 * 33], s[3 * 33]); o.z = cvt_pk_bf16(s[4 * 33], s[5 * 33]); o.w = cvt_pk_bf16(s[6 * 33], s[7 * 33]);
            *(u32x4*)((bf16_t*)WTv + (size_t)(n0 + n) * K + k0 + 8 * c) = o; } }
    LDS_WAIT(); asm volatile("" ::: "memory");
}
__device__ __forceinline__ void cast_rows(Frame& F, const float* x, bf16_t* xb, rs_t* rs, unsigned char* xb8) {
    const int tid_ = opq_tid(), lane = tid_ & 63, wave = __builtin_amdgcn_readfirstlane(tid_ >> 6);
    const int gw = F.bid * NWAVES + wave, NGW = F.G * NWAVES;
    for (int m = gw; m < M; m += NGW) {
        const f32x4* xr = (const f32x4*)(x + (size_t)m * D) + lane;
        f32x4 v[8]; float s = 0.f;
#pragma unroll
        for (int j = 0; j < 8; ++j) { v[j] = xr[64 * j]; s += (v[j].x * v[j].x + v[j].y * v[j].y) + (v[j].z * v[j].z + v[j].w * v[j].w); }
        s = wave_sum(s);
        u32x2* o8 = (u32x2*)(xb + (size_t)m * D) + lane;
#pragma unroll
        for (int j = 0; j < 8; ++j) { u32x2 w; w.x = cvt_pk_bf16(v[j].x, v[j].y); w.y = cvt_pk_bf16(v[j].z, v[j].w); o8[64 * j] = w; }
        unsigned* o4 = (unsigned*)(xb8 + (size_t)m * D) + lane;
#pragma unroll
        for (int j = 0; j < 8; ++j) { unsigned q8 = 0u; q8 = __builtin_amdgcn_cvt_pk_fp8_f32(v[j].x, v[j].y, q8, false); q8 = __builtin_amdgcn_cvt_pk_fp8_f32(v[j].z, v[j].w, q8, true); o4[64 * j] = q8; }
        if (lane == 0) rs[m] = (rs_t)(s * RS_SCALE + 0.5f);
    }
}
struct TJob { const float* src; const float* gp; unsigned char* dst; int ldw, K; bool valid, fp8; };
__device__ __forceinline__ void tj_load(const TJob& j, f32x4 (&v)[8], float (&gk)[8]) {
#pragma unroll
    for (int i = 0; i < 8; ++i) { v[i] = j.valid ? *(const f32x4*)(j.src + (size_t)(8 * i) * j.ldw) : (f32x4){0.f, 0.f, 0.f, 0.f}; gk[i] = j.gp ? j.gp[8 * i] : 1.0f; }
}
__device__ __forceinline__ void tj_process(const TJob& j, const f32x4 (&v)[8], const float (&gk)[8], LAS float* scr, int lane) {
    const int nq = lane & 7, kr = lane >> 3;
#pragma unroll
    for (int i = 0; i < 8; ++i) { const int kk = 8 * i + kr; LAS float* d = scr + kk * 33 + 4 * nq; d[0] = v[i].x * gk[i]; d[1] = v[i].y * gk[i]; d[2] = v[i].z * gk[i]; d[3] = v[i].w * gk[i]; }
    LDS_WAIT(); asm volatile("" ::: "memory");
    const int c = lane & 7;
#pragma unroll
    for (int q = 0; q < 4; ++q) { const int n = (lane >> 3) + 8 * q; const LAS float* s = scr + (8 * c) * 33 + n;
        if (j.fp8) { u32x2 o; o.x = 0u; o.y = 0u;
            o.x = __builtin_amdgcn_cvt_pk_fp8_f32(s[0 * 33] * W8_SCALE, s[1 * 33] * W8_SCALE, o.x, false); o.x = __builtin_amdgcn_cvt_pk_fp8_f32(s[2 * 33] * W8_SCALE, s[3 * 33] * W8_SCALE, o.x, true);
            o.y = __builtin_amdgcn_cvt_pk_fp8_f32(s[4 * 33] * W8_SCALE, s[5 * 33] * W8_SCALE, o.y, false); o.y = __builtin_amdgcn_cvt_pk_fp8_f32(s[6 * 33] * W8_SCALE, s[7 * 33] * W8_SCALE, o.y, true);
            *(u32x2*)(j.dst + (size_t)(8 * q) * j.K) = o; }
        else { u32x4 o; o.x = cvt_pk_bf16(s[0 * 33], s[1 * 33]); o.y = cvt_pk_bf16(s[2 * 33], s[3 * 33]); o.z = cvt_pk_bf16(s[4 * 33], s[5 * 33]); o.w = cvt_pk_bf16(s[6 * 33], s[7 * 33]);
            *(u32x4*)(j.dst + (size_t)(16 * q) * j.K) = o; } }
    LDS_WAIT(); asm volatile("" ::: "memory");
}
__device__ __forceinline__ void p0_convert(Frame& F, int l) {
    const int tid_ = opq_tid(), lane = tid_ & 63, wave = __builtin_amdgcn_readfirstlane(tid_ >> 6);
    LAS float* scr = (LAS float*)(F.lds + wave * 16384);
    const int gw = F.bid * NWAVES + wave, NGW = F.G * NWAVES;
    constexpr int I_IN = (D / 64) * (NB / 32), I_8 = (D / 64) * (N8 / 32), I_BR = (D / 64) * (D / 32), I_O = I_BR, I_FI = (D / 64) * (NFI / 32), I_FO = (DFF / 64) * (D / 32);
    constexpr int NITEMS = I_IN + I_8 + I_BR + I_O + I_FI + I_FO;
    const int nq = lane & 7, kr = lane >> 3;
    auto describe = [&](int it) -> TJob {
        const float* w_in = P_w_in + (size_t)l * D * DIN; const float* w_br = P_w_branch + (size_t)l * D * D; const float* w_o = P_w_out + (size_t)l * D * D;
        const float* w_fi = P_w_ffn_in + (size_t)l * D * NFI; const float* w_fo = P_w_ffn_out + (size_t)l * DFF * D;
        auto fin = [&](const float* W, int ldw, void* WT, int K, int kb, int nb, const float* gain, int sc, bool fp8) -> TJob {
            TJob j; const int k0 = 64 * kb, n0 = 32 * nb;
            j.src = W + (size_t)(k0 + kr) * ldw + sc; j.gp = gain ? gain + k0 + kr : nullptr; j.ldw = ldw; j.K = K; j.valid = sc >= 0; j.fp8 = fp8;
            j.dst = (unsigned char*)WT + ((size_t)(n0 + (lane >> 3)) * K + k0 + 8 * (lane & 7)) * (fp8 ? 1 : 2); return j; };
        int r = it;
        if (r < I_IN) { const int nb = r % (NB / 32), n = 32 * nb + 4 * nq;
            return fin(w_in, DIN, P_WIN, D, r / (NB / 32), nb, P_norm1_g + l * D, n < 1536 ? 4608 + n : (n < 3072 ? 6160 + (n - 1536) : (n < 3088 ? 6144 + (n - 3072) : -1)), false); } r -= I_IN;
        if (r < I_8) { const int nb = r % (N8 / 32), n = 32 * nb + 4 * nq;
            return fin(w_in, DIN, P_W8, D, r / (N8 / 32), nb, P_norm1_g + l * D, n < 4608 ? n : 7696 + (n - 4608), true); } r -= I_8;
        if (r < I_BR) { const int nb = r % (D / 32); return fin(w_br, D, P_WBR, D, r / (D / 32), nb, nullptr, 32 * nb + 4 * nq, false); } r -= I_BR;
        if (r < I_O) { const int nb = r % (D / 32); return fin(w_o, D, P_WO, D, r / (D / 32), nb, nullptr, 32 * nb + 4 * nq, false); } r -= I_O;
        if (r < I_FI) { const int nb = r % (NFI / 32), n = 32 * nb + 4 * nq, t = n >> 8, jj = n & 255;
            return fin(w_fi, NFI, P_WFI, D, r / (NFI / 32), nb, P_norm2_g + l * D, jj < 128 ? 128 * t + jj : DFF + 128 * t + (jj - 128), false); } r -= I_FI;
        { const int nb = r % (D / 32); return fin(w_fo, D, P_WFO, DFF, r / (D / 32), nb, nullptr, 32 * nb + 4 * nq, false); }
    };
    f32x4 vA[8], vB[8]; float gA[8], gB[8]; TJob jA, jB;
    int it = gw;
    if (it < NITEMS) { jA = describe(it); tj_load(jA, vA, gA); }
    for (; it < NITEMS; it += 2 * NGW) {
        const bool hasB = it + NGW < NITEMS;
        if (hasB) { jB = describe(it + NGW); tj_load(jB, vB, gB); }
        tj_process(jA, vA, gA, scr, lane);
        if (it + 2 * NGW < NITEMS) { jA = describe(it + 2 * NGW); tj_load(jA, vA, gA); }
        if (hasB) tj_process(jB, vB, gB, scr, lane);
    }
}

__device__ __forceinline__ unsigned off_b(unsigned row, unsigned ch) { return 256u * row + 16u * (ch ^ (((row & 3u) << 2) | ((row >> 2) & 3u))); }
__device__ __forceinline__ s16x4 tr16(const LAS unsigned char* p) {
    typedef short v4i16_t __attribute__((ext_vector_type(4)));
    return __builtin_bit_cast(s16x4, __builtin_amdgcn_ds_read_tr16_b64_v4i16((LAS v4i16_t*)p));
}
__device__ __forceinline__ bf16x8 cat8(s16x4 a, s16x4 b) { return (bf16x8){a[0], a[1], a[2], a[3], b[0], b[1], b[2], b[3]}; }
__device__ __forceinline__ int t5_bucket(int td) {
    if (td < 16) return td;
    int b = 16;
    b += td >= 22; b += td >= 30; b += td >= 40; b += td >= 54; b += td >= 73; b += td >= 99; b += td >= 134; b += td >= 182;
    b += td >= 246; b += td >= 332; b += td >= 450; b += td >= 609; b += td >= 825; b += td >= 1117; b += td >= 1513;
    return b;
}
constexpr int ATT_K = 0, ATT_V = 65536, ATT_BIAS = 131072;
__device__ __forceinline__ void attn_norm_store(LAS unsigned char* Kimg, LAS unsigned char* Vimg, int row, int ch, u32x4 kv, u32x4 vv, f32x4 gk0, f32x4 gk1) {
    float kf[8] = {bflo(kv.x), bfhi(kv.x), bflo(kv.y), bfhi(kv.y), bflo(kv.z), bfhi(kv.z), bflo(kv.w), bfhi(kv.w)};
    float ss = 0.f;
#pragma unroll
    for (int j = 0; j < 8; ++j) ss += kf[j] * kf[j];
    ss += __shfl_xor(ss, 1); ss += __shfl_xor(ss, 2); ss += __shfl_xor(ss, 4); ss += __shfl_xor(ss, 8);
    const float rs = 1.0f / sqrtf(ss * (1.f / 128.f) + EPS);
    u32x4 ko; ko.x = cvt_pk_bf16(kf[0] * rs * gk0.x, kf[1] * rs * gk0.y); ko.y = cvt_pk_bf16(kf[2] * rs * gk0.z, kf[3] * rs * gk0.w);
    ko.z = cvt_pk_bf16(kf[4] * rs * gk1.x, kf[5] * rs * gk1.y); ko.w = cvt_pk_bf16(kf[6] * rs * gk1.z, kf[7] * rs * gk1.w);
    const unsigned o = off_b((unsigned)row, (unsigned)ch);
    *(LAS u32x4*)(Kimg + o) = ko; *(LAS u32x4*)(Vimg + o) = vv;
}
__device__ __forceinline__ void attn_seg(Frame& F, int seg, int l) {
    const int rnb = seg & 7, h = (seg >> 3) & 3, bg = seg >> 5, g = bg % 3, b = bg / 3;
    const int dsh = 2 * g, dil = 1 << dsh, nb = 32 >> dsh;
    const bf16_t* Zb = P_Z + (size_t)b * SEQ * NZ;
    const int qcol = g * 512 + h * 128;
    LAS unsigned char* Kimg = F.lds + ATT_K; LAS unsigned char* Vimg = F.lds + ATT_V; LAS float* biasT = (LAS float*)(F.lds + ATT_BIAS);
    const int tid = opq_tid(), lane = tid & 63, w = __builtin_amdgcn_readfirstlane(tid >> 6), fr = lane & 15, fq = lane >> 4;
    if (tid < 192) { const int d = tid - 32; biasT[tid] = (d >= 0 && d <= 128) ? P_rel_bias[t5_bucket(d << dsh) * 12 + g * 4 + h] : -3.0e38f; }
    LAS float* gqL = biasT + 256;
    if (tid >= 256 && tid < 384) gqL[tid - 256] = P_q_norm_g[l * 128 + (tid - 256)];
    const int ch = tid & 15, srow = tid >> 4;
    const f32x4 gk0 = *(const f32x4*)(P_k_norm_g + l * 128 + ch * 8), gk1 = *(const f32x4*)(P_k_norm_g + l * 128 + ch * 8 + 4);
    u32x4 kc[4], vc[4];
    {
        const int rn = 4 * rnb, r = rn / nb, n = rn % nb;
#pragma unroll
        for (int it = 0; it < 4; ++it) { const bf16_t* p = Zb + (size_t)((128 * n + it * 32 + srow) * dil + r) * NZ + qcol + ch * 8; kc[it] = *(const u32x4*)(p + ZK); vc[it] = *(const u32x4*)(p + ZV); }
    }
#pragma unroll 1
    for (int pos = 0; pos < 4; ++pos) {
        const int rn = 4 * rnb + pos, r = rn / nb, n = rn % nb;
        const int cs = (n & 1) << 7, ps = cs ^ 128;
        const int qi = 16 * w + fr, qtok = (128 * n + qi) * dil + r;
        const size_t qrow = (size_t)b * SEQ + qtok;
        u32x4 qv[4];
        { const bf16_t* qp = P_Z + qrow * NZ + ZQ + qcol + 8 * fq;
#pragma unroll
          for (int ks = 0; ks < 4; ++ks) qv[ks] = *(const u32x4*)(qp + 32 * ks); }
        if (n == 0) {
#pragma unroll
            for (int it = 0; it < 4; ++it) { const unsigned o = off_b((unsigned)(ps + it * 32 + srow), (unsigned)ch); *(LAS u32x4*)(Kimg + o) = (u32x4){0u, 0u, 0u, 0u}; *(LAS u32x4*)(Vimg + o) = (u32x4){0u, 0u, 0u, 0u}; }
        } else if (pos == 0) {
            u32x4 kp[4], vp[4];
#pragma unroll
            for (int it = 0; it < 4; ++it) { const bf16_t* p = Zb + (size_t)((128 * (n - 1) + it * 32 + srow) * dil + r) * NZ + qcol + ch * 8; kp[it] = *(const u32x4*)(p + ZK); vp[it] = *(const u32x4*)(p + ZV); }
#pragma unroll
            for (int it = 0; it < 4; ++it) attn_norm_store(Kimg, Vimg, ps + it * 32 + srow, ch, kp[it], vp[it], gk0, gk1);
        }
#pragma unroll
        for (int it = 0; it < 4; ++it) attn_norm_store(Kimg, Vimg, cs + it * 32 + srow, ch, kc[it], vc[it], gk0, gk1);
        if (pos < 3) {
            const int rn2 = rn + 1, r2 = rn2 / nb, n2 = rn2 % nb;
#pragma unroll
            for (int it = 0; it < 4; ++it) { const bf16_t* p = Zb + (size_t)((128 * n2 + it * 32 + srow) * dil + r2) * NZ + qcol + ch * 8; kc[it] = *(const u32x4*)(p + ZK); vc[it] = *(const u32x4*)(p + ZV); }
        }
        bf16x8 qf[4];
        {
            float ss = 0.f;
#pragma unroll
            for (int ks = 0; ks < 4; ++ks) {
                const float a0 = bflo(qv[ks].x), a1 = bfhi(qv[ks].x), a2 = bflo(qv[ks].y), a3 = bfhi(qv[ks].y), a4 = bflo(qv[ks].z), a5 = bfhi(qv[ks].z), a6 = bflo(qv[ks].w), a7 = bfhi(qv[ks].w);
                ss += (a0 * a0 + a1 * a1) + (a2 * a2 + a3 * a3) + (a4 * a4 + a5 * a5) + (a6 * a6 + a7 * a7); }
            ss += __shfl_xor(ss, 16); ss += __shfl_xor(ss, 32);
            const float rs = (1.0f / sqrtf(ss * (1.f / 128.f) + EPS)) * 0.08838834764831845f;
#pragma unroll
            for (int ks = 0; ks < 4; ++ks) { const f32x4 g0 = *(const LAS f32x4*)(gqL + 32 * ks + 8 * fq), g1 = *(const LAS f32x4*)(gqL + 32 * ks + 8 * fq + 4);
                u32x4 o; o.x = cvt_pk_bf16(bflo(qv[ks].x) * rs * g0.x, bfhi(qv[ks].x) * rs * g0.y); o.y = cvt_pk_bf16(bflo(qv[ks].y) * rs * g0.z, bfhi(qv[ks].y) * rs * g0.w);
                o.z = cvt_pk_bf16(bflo(qv[ks].z) * rs * g1.x, bfhi(qv[ks].z) * rs * g1.y); o.w = cvt_pk_bf16(bflo(qv[ks].w) * rs * g1.z, bfhi(qv[ks].w) * rs * g1.w);
                qf[ks] = __builtin_bit_cast(bf16x8, o); }
        }
        WG_SYNC();
        const int kb0 = w >> 1;
        f32x4 s[5][2];
#pragma unroll
        for (int kbi = 0; kbi < 5; ++kbi)
#pragma unroll
            for (int hb = 0; hb < 2; ++hb) {
                const unsigned krow = (unsigned)((32 * (kb0 + kbi) + 8 * (fr >> 2) + (fr & 3) + 4 * hb) ^ ps);
                f32x4 a = (f32x4){0.f, 0.f, 0.f, 0.f};
#pragma unroll
                for (int ks = 0; ks < 4; ++ks) { const bf16x8 kfr = *(const LAS bf16x8*)(Kimg + off_b(krow, (unsigned)(4 * ks + fq))); a = __builtin_amdgcn_mfma_f32_16x16x32_bf16(kfr, qf[ks], a, 0, 0, 0); }
                s[kbi][hb] = a;
            }
        float mx = -3.0e38f;
        const LAS float* bt = biasT + (qi + 160 - 32 * kb0 - 8 * fq);
        float bv[5][2][4];
#pragma unroll
        for (int kbi = 0; kbi < 5; ++kbi)
#pragma unroll
            for (int hb = 0; hb < 2; ++hb)
#pragma unroll
                for (int i = 0; i < 4; ++i) bv[kbi][hb][i] = bt[-(32 * kbi + 4 * hb + i)];
#pragma unroll
        for (int kbi = 0; kbi < 5; ++kbi) {
            const float dm = ((n == 0) && (kb0 + kbi < 4)) ? -3.0e38f : 0.f;
#pragma unroll
            for (int hb = 0; hb < 2; ++hb)
#pragma unroll
                for (int i = 0; i < 4; ++i) {
                    const float v = (s[kbi][hb][i] + bv[kbi][hb][i]) + dm;
                    s[kbi][hb][i] = v; mx = fmaxf(mx, v);
                }
        }
        mx = fmaxf(mx, __shfl_xor(mx, 16)); mx = fmaxf(mx, __shfl_xor(mx, 32));
        float sum = 0.f; bf16x8 pf[5];
#pragma unroll
        for (int kbi = 0; kbi < 5; ++kbi) {
            float p[8];
#pragma unroll
            for (int hb = 0; hb < 2; ++hb)
#pragma unroll
                for (int i = 0; i < 4; ++i) { const float e = __expf(s[kbi][hb][i] - mx); p[4 * hb + i] = e; sum += e; }
            u32x4 o; o.x = cvt_pk_bf16(p[0], p[1]); o.y = cvt_pk_bf16(p[2], p[3]); o.z = cvt_pk_bf16(p[4], p[5]); o.w = cvt_pk_bf16(p[6], p[7]);
            pf[kbi] = __builtin_bit_cast(bf16x8, o);
        }
        sum += __shfl_xor(sum, 16); sum += __shfl_xor(sum, 32);
        const float inv = 1.0f / sum;
        bf16_t* op = P_AO + ((size_t)g * M + qrow) * 512 + h * 128 + 8 * fq;
        const unsigned tq = (unsigned)((lane & 15) >> 2), tp = (unsigned)(lane & 3);
#pragma unroll
        for (int cp = 0; cp < 4; ++cp) {
            f32x4 o0 = (f32x4){0.f, 0.f, 0.f, 0.f}, o1 = (f32x4){0.f, 0.f, 0.f, 0.f};
#pragma unroll
            for (int kbi = 0; kbi < 5; ++kbi) {
                const unsigned r0 = ((unsigned)(32 * (kb0 + kbi) + 8 * fq) + tq) ^ (unsigned)ps;
                const LAS unsigned char* a0 = Vimg + off_b(r0, (unsigned)(4 * cp) + tp); const LAS unsigned char* a1 = Vimg + off_b(r0 + 4u, (unsigned)(4 * cp) + tp);
                o0 = __builtin_amdgcn_mfma_f32_16x16x32_bf16(cat8(tr16(a0), tr16(a1)), pf[kbi], o0, 0, 0, 0);
                o1 = __builtin_amdgcn_mfma_f32_16x16x32_bf16(cat8(tr16(a0 + 8), tr16(a1 + 8)), pf[kbi], o1, 0, 0, 0);
            }
            u32x4 wv; wv.x = cvt_pk_bf16(o0[0] * inv, o0[1] * inv); wv.y = cvt_pk_bf16(o0[2] * inv, o0[3] * inv); wv.z = cvt_pk_bf16(o1[0] * inv, o1[1] * inv); wv.w = cvt_pk_bf16(o1[2] * inv, o1[3] * inv);
            *(u32x4*)(op + 32 * cp) = wv;
        }
        if (fq == 0) P_LSE[((size_t)g * M + qrow) * 4 + h] = mx + __logf(sum);
        WG_SYNC();
    }
}

constexpr int G1_P = 208;
constexpr int G1_QS = 0, G1_KS = 64 * G1_P, G1_KH = 2 * 64 * G1_P;
constexpr int G1_V = 3 * 64 * G1_P;
constexpr int G1_V_P = 400;
constexpr int G1_GL = G1_V + 64 * G1_V_P;
constexpr int G1_TOT = G1_GL + 4096;
constexpr int G1_END = G1_TOT + 1536;
__device__ __forceinline__ bf16x8 tr_frag(const LAS unsigned char* img, int pitch, int row0, int col0, int lane) {
    const int g = lane >> 4, q = (lane & 15) >> 2, p = lane & 3;
    const LAS unsigned char* a = img + (row0 + 8 * g + q) * pitch + (col0 + 4 * p) * 2;
    return cat8(tr16(a), tr16(a + 4 * pitch));
}
__device__ __forceinline__ bf16x8 tr_frag_p(const LAS unsigned char* img, int pitch, int row0, int k, int e, int lane) {
    const int g = lane >> 4, q = (lane & 15) >> 2, p = lane & 3;
    const LAS unsigned char* a = img + (row0 + 8 * g + q) * pitch + (32 * k + 8 * p + 4 * e) * 2;
    return cat8(tr16(a), tr16(a + 4 * pitch));
}
__device__ __forceinline__ void gla1_unit(Frame& F, int unit, int l) {
    const int h = unit & 3, c = (unit >> 2) & 63, b = unit >> 8;
    const size_t row0 = (size_t)b * SEQ + 64 * c;
    const bf16_t* Zr = P_Z + row0 * NZ;
    const int tid = opq_tid(), lane = tid & 63, w = __builtin_amdgcn_readfirstlane(tid >> 6);
    LAS unsigned char* QS = F.lds + G1_QS; LAS unsigned char* KS = F.lds + G1_KS; LAS unsigned char* KH = F.lds + G1_KH; LAS unsigned char* VI = F.lds + G1_V;
    LAS float* GLs = (LAS float*)(F.lds + G1_GL); LAS float* TOT = (LAS float*)(F.lds + G1_TOT);
    const int k = tid & 127, tg = tid >> 7;
    const bool act = k < GLA_DK;
    const int kc = act ? k : 0;
    {
        const int t = tid >> 3, j2 = (tid & 7) * 2; const unsigned gw2 = *(const unsigned*)(Zr + (size_t)t * NZ + ZGL + j2);
        u32x4 vv[3], qq[2], kk[2];
#pragma unroll
        for (int i = 0; i < 3; ++i) { const int idx = tid + 512 * i, sr = idx / 24, ch = idx % 24; vv[i] = *(const u32x4*)(Zr + (size_t)sr * NZ + ZBV + h * GLA_DV + ch * 8); }
#pragma unroll
        for (int i = 0; i < 2; ++i) { const int idx = tid + 512 * i; if (idx < 768) { const int sr = idx / 12, ch = idx % 12; const bf16_t* p = Zr + (size_t)sr * NZ + h * GLA_DK + ch * 8; qq[i] = *(const u32x4*)(p + ZBQ); kk[i] = *(const u32x4*)(p + ZBK); } }
        GLs[t * 16 + j2] = bflo(gw2); GLs[t * 16 + j2 + 1] = bfhi(gw2);
#pragma unroll
        for (int i = 0; i < 3; ++i) { const int idx = tid + 512 * i, sr = idx / 24, ch = idx % 24; *(LAS u32x4*)(VI + sr * G1_V_P + ch * 16) = vv[i]; }
#pragma unroll
        for (int i = 0; i < 2; ++i) { const int idx = tid + 512 * i; if (idx < 768) { const int sr = idx / 12, ch = idx % 12; *(LAS u32x4*)(QS + sr * G1_P + ch * 16) = qq[i]; *(LAS u32x4*)(KS + sr * G1_P + ch * 16) = kk[i]; } }
    }
    float wu[16];
#pragma unroll
    for (int j = 0; j < 16; ++j) wu[j] = P_gla_gate_up[((size_t)l * 16 + j) * 384 + h * GLA_DK + kc];
    const float bg = P_gla_gate_b[l * 384 + h * GLA_DK + kc];
    WG_SYNC();
    float bcum[16];
    {
        float run = 0.f;
#pragma unroll
        for (int i = 0; i < 16; ++i) {
            const LAS f32x4* gp = (const LAS f32x4*)(GLs + (16 * tg + i) * 16);
            const f32x4 g0 = gp[0], g1 = gp[1], g2 = gp[2], g3 = gp[3];
            float xg = bg + g0.x * wu[0] + g0.y * wu[1] + g0.z * wu[2] + g0.w * wu[3] + g1.x * wu[4] + g1.y * wu[5] + g1.z * wu[6] + g1.w * wu[7]
                     + g2.x * wu[8] + g2.y * wu[9] + g2.z * wu[10] + g2.w * wu[11] + g3.x * wu[12] + g3.y * wu[13] + g3.z * wu[14] + g3.w * wu[15];
            const float ls = fminf(xg, 0.f) - __logf(1.0f + __expf(-fabsf(xg)));
            run += ls * (1.0f / 16.0f); bcum[i] = run;
        }
        if (act) TOT[tg * GLA_DK + k] = run;
    }
    WG_SYNC();
    {
        float offs = 0.f, blast = 0.f;
#pragma unroll
        for (int q = 0; q < 4; ++q) { const float tv = TOT[q * GLA_DK + kc]; blast += tv; offs += q < tg ? tv : 0.f; }
        if (act) {
            if (tg == 0) P_DL[(size_t)unit * GLA_DK + k] = __expf(blast);
#pragma unroll
            for (int i = 0; i < 16; ++i) {
                const int t = 16 * tg + i; const float bb = bcum[i] + offs;
                LAS bf16_t* qa = (LAS bf16_t*)(QS + t * G1_P + k * 2); LAS bf16_t* ka = (LAS bf16_t*)(KS + t * G1_P + k * 2);
                const float qv = bflo((unsigned)*qa), kv = bflo((unsigned)*ka);
                *qa = (bf16_t)(cvt_pk_bf16(qv * 0.10206207261596575f * __expf(bb), 0.f) & 0xffffu);
                *ka = (bf16_t)(cvt_pk_bf16(kv * __expf(-bb), 0.f) & 0xffffu);
                *(LAS bf16_t*)(KH + t * G1_P + k * 2) = (bf16_t)(cvt_pk_bf16(kv * __expf(blast - bb), 0.f) & 0xffffu);
            }
        }
    }
    WG_SYNC();
    {
        bf16_t* QTp = P_QT; bf16_t* KTp = P_KT;
#pragma unroll
        for (int i = 0; i < 2; ++i) { const int idx = tid + 512 * i; if (idx < 768) { const int sr = idx / 12, ch = idx % 12; const size_t go = (row0 + sr) * 384 + h * GLA_DK + ch * 8;
            *(u32x4*)(QTp + go) = *(const LAS u32x4*)(QS + sr * G1_P + ch * 16); *(u32x4*)(KTp + go) = *(const LAS u32x4*)(KS + sr * G1_P + ch * 16); } }
    }
    bf16_t* SLu = P_SL + (size_t)unit * GLA_DV * GLA_DK;
    const int fr = lane & 15, fq = lane >> 4;
#pragma unroll 3
    for (int j = 0; j < 9; ++j) {
        const int tau = 9 * w + j, vt = tau / 6, kt = tau % 6;
        f32x4 a = (f32x4){0.f, 0.f, 0.f, 0.f};
#pragma unroll
        for (int ks = 0; ks < 2; ++ks) {
            const bf16x8 af = tr_frag(VI, G1_V_P, 32 * ks, 16 * vt, lane);
            const bf16x8 bfv = tr_frag(KH, G1_P, 32 * ks, 16 * kt, lane);
            a = __builtin_amdgcn_mfma_f32_16x16x32_bf16(bfv, af, a, 0, 0, 0);
        }
        { u32x2 wv; wv.x = cvt_pk_bf16(a[0], a[1]); wv.y = cvt_pk_bf16(a[2], a[3]); *(u32x2*)(SLu + (size_t)(16 * vt + fr) * GLA_DK + 16 * kt + 4 * fq) = wv; }
    }
    WG_SYNC();
}
__device__ __forceinline__ void gla_scan(Frame& F) {
    const int ntask = BATCH * 4 * GLA_DV * 12;
    const bf16_t* SLp = P_SL; const float* DLp = P_DL; bf16_t* SPp = P_SP;
    for (int task = F.bid * NT + opq_tid(); task < ntask; task += F.G * NT) {
        const int ko = task % 12, vd = (task / 12) % GLA_DV, bh = task / (12 * GLA_DV), h = bh & 3, b = bh >> 2;
        float st[8];
#pragma unroll
        for (int j = 0; j < 8; ++j) st[j] = 0.f;
#pragma unroll 4
        for (int c = 0; c < NCHK; ++c) {
            const size_t unit = ((size_t)b * NCHK + c) * 4 + h;
            const size_t e = (unit * GLA_DV + vd) * GLA_DK + ko * 8;
            const u32x4 sw = *(const u32x4*)(SLp + e); const f32x4 s0 = (f32x4){bflo(sw.x), bfhi(sw.x), bflo(sw.y), bfhi(sw.y)}, s1 = (f32x4){bflo(sw.z), bfhi(sw.z), bflo(sw.w), bfhi(sw.w)};
            const f32x4 d0 = *(const f32x4*)(DLp + unit * GLA_DK + ko * 8), d1 = *(const f32x4*)(DLp + unit * GLA_DK + ko * 8 + 4);
            u32x4 o; o.x = cvt_pk_bf16(st[0], st[1]); o.y = cvt_pk_bf16(st[2], st[3]); o.z = cvt_pk_bf16(st[4], st[5]); o.w = cvt_pk_bf16(st[6], st[7]);
            *(u32x4*)(SPp + e) = o;
            st[0] = d0.x * st[0] + s0.x; st[1] = d0.y * st[1] + s0.y; st[2] = d0.z * st[2] + s0.z; st[3] = d0.w * st[3] + s0.w;
            st[4] = d1.x * st[4] + s1.x; st[5] = d1.y * st[5] + s1.y; st[6] = d1.z * st[6] + s1.z; st[7] = d1.w * st[7] + s1.w;
        }
    }
}
constexpr int G3_V_P = 400;
__device__ __forceinline__ void gla3_unit(Frame& F, int unit, int l) {
    const int cp = unit & 31, h = (unit >> 5) & 3, b = unit >> 7;
    const int tid = opq_tid(), lane = tid & 63, w = __builtin_amdgcn_readfirstlane(tid >> 6), fr = lane & 15, fq = lane >> 4;
    const int cw = w >> 2, tt = w & 3, c = 2 * cp + cw;
    const size_t row0 = (size_t)b * SEQ + 64 * c;
    LAS unsigned char* VI = F.lds + cw * (64 * G3_V_P);
    u32x4 vreg[6];
    {
        const int lt = tid & 255; const bf16_t* Zr = P_Z + row0 * NZ + ZBV + h * GLA_DV;
#pragma unroll
        for (int i = 0; i < 6; ++i) { const int idx = lt + 256 * i, sr = idx / 24, ch = idx % 24; vreg[i] = *(const u32x4*)(Zr + (size_t)sr * NZ + ch * 8); }
    }
    bf16x8 qf[3];
    { const bf16_t* qp = P_QT + (row0 + 16 * tt + fr) * 384 + h * GLA_DK + 8 * fq;
#pragma unroll
      for (int ks = 0; ks < 3; ++ks) qf[ks] = *(const bf16x8*)(qp + 32 * ks); }
    bf16x8 pf[2];
    const int nblk = (tt >> 1) + 1;
#pragma unroll
    for (int blk = 0; blk < 2; ++blk) {
        u32x4 pw = (u32x4){0u, 0u, 0u, 0u};
        if (blk < nblk) {
            float p[8];
#pragma unroll
            for (int hb = 0; hb < 2; ++hb) {
                const int srow = 32 * blk + 8 * (fr >> 2) + (fr & 3) + 4 * hb;
                const bf16_t* kp = P_KT + (row0 + srow) * 384 + h * GLA_DK + 8 * fq;
                f32x4 a = (f32x4){0.f, 0.f, 0.f, 0.f};
#pragma unroll
                for (int ks = 0; ks < 3; ++ks) a = __builtin_amdgcn_mfma_f32_16x16x32_bf16(*(const bf16x8*)(kp + 32 * ks), qf[ks], a, 0, 0, 0);
#pragma unroll
                for (int i = 0; i < 4; ++i) { const int sidx = 32 * blk + 8 * fq + 4 * hb + i; p[4 * hb + i] = sidx <= 16 * tt + fr ? a[i] : 0.f; }
            }
            pw.x = cvt_pk_bf16(p[0], p[1]); pw.y = cvt_pk_bf16(p[2], p[3]); pw.z = cvt_pk_bf16(p[4], p[5]); pw.w = cvt_pk_bf16(p[6], p[7]);
        }
        pf[blk] = __builtin_bit_cast(bf16x8, pw);
    }
    const size_t gu = ((size_t)b * NCHK + c) * 4 + h;
    const bf16_t* SPu = P_SP + gu * GLA_DV * GLA_DK;
    f32x4 o[12];
#pragma unroll
    for (int vt = 0; vt < 12; ++vt) {
        f32x4 a = (f32x4){0.f, 0.f, 0.f, 0.f};
        const bf16_t* sp = SPu + (size_t)(32 * (vt >> 1) + 8 * (fr >> 2) + 4 * (vt & 1) + (fr & 3)) * GLA_DK + 8 * fq;
#pragma unroll
        for (int ks = 0; ks < 3; ++ks) a = __builtin_amdgcn_mfma_f32_16x16x32_bf16(*(const bf16x8*)(sp + 32 * ks), qf[ks], a, 0, 0, 0);
        o[vt] = a;
    }
    {
        const int lt = tid & 255;
#pragma unroll
        for (int i = 0; i < 6; ++i) { const int idx = lt + 256 * i, sr = idx / 24, ch = idx % 24; *(LAS u32x4*)(VI + sr * G3_V_P + ch * 16) = vreg[i]; }
    }
    WG_SYNC();
    float ss = 0.f;
#pragma unroll
    for (int vt = 0; vt < 12; ++vt) {
        f32x4 a = o[vt];
#pragma unroll
        for (int blk = 0; blk < 2; ++blk) { const bf16x8 vf = tr_frag_p(VI, G3_V_P, 32 * blk, vt >> 1, vt & 1, lane); a = __builtin_amdgcn_mfma_f32_16x16x32_bf16(vf, pf[blk], a, 0, 0, 0); }
        o[vt] = a; ss += (a[0] * a[0] + a[1] * a[1]) + (a[2] * a[2] + a[3] * a[3]);
    }
    ss += __shfl_xor(ss, 16); ss += __shfl_xor(ss, 32);
    const float rs = 1.0f / sqrtf(ss * (1.f / GLA_DV) + EPS);
    bf16_t* op = P_OMIX + (row0 + 16 * tt + fr) * D + 512 + h * GLA_DV + 8 * fq;
    const float* go = P_gla_out_g + l * GLA_DV + 8 * fq;
#pragma unroll
    for (int k = 0; k < 6; ++k) { const f32x4 g0 = *(const f32x4*)(go + 32 * k), g1 = *(const f32x4*)(go + 32 * k + 4);
        u32x4 wv; wv.x = cvt_pk_bf16(o[2 * k][0] * rs * g0.x, o[2 * k][1] * rs * g0.y); wv.y = cvt_pk_bf16(o[2 * k][2] * rs * g0.z, o[2 * k][3] * rs * g0.w);
        wv.z = cvt_pk_bf16(o[2 * k + 1][0] * rs * g1.x, o[2 * k + 1][1] * rs * g1.y); wv.w = cvt_pk_bf16(o[2 * k + 1][2] * rs * g1.z, o[2 * k + 1][3] * rs * g1.w);
        *(u32x4*)(op + 32 * k) = wv; }
    WG_SYNC();
}

constexpr int SG_V_P = 400;
constexpr int SG_ST = 128 * SG_V_P;
__device__ __forceinline__ void sgu_unit(Frame& F, int unit, int l) {
    const int n = unit & 31, b = unit >> 5;
    const size_t row0 = (size_t)b * SEQ + 128 * n;
    const bf16_t* Zr = P_Z + row0 * NZ;
    const int tid = opq_tid(), lane = tid & 63, w = __builtin_amdgcn_readfirstlane(tid >> 6), fr = lane & 15, fq = lane >> 4;
    LAS unsigned char* VN = F.lds; LAS float* ST = (LAS float*)(F.lds + SG_ST);
    {
        const int t = tid >> 2, qd = tid & 3; const bf16_t* p = Zr + (size_t)t * NZ + ZCV + 192 * qd;
        float s1 = 0.f, s2 = 0.f;
#pragma unroll
        for (int hb = 0; hb < 2; ++hb) {
            u32x4 v[12];
#pragma unroll
            for (int c = 0; c < 12; ++c) v[c] = *(const u32x4*)(p + 96 * hb + 8 * c);
#pragma unroll
            for (int c = 0; c < 12; ++c) {
                const float a0 = gelu_tanh(bflo(v[c].x)), a1 = gelu_tanh(bfhi(v[c].x)), a2 = gelu_tanh(bflo(v[c].y)), a3 = gelu_tanh(bfhi(v[c].y));
                const float a4 = gelu_tanh(bflo(v[c].z)), a5 = gelu_tanh(bfhi(v[c].z)), a6 = gelu_tanh(bflo(v[c].w)), a7 = gelu_tanh(bfhi(v[c].w));
                s1 += ((a0 + a1) + (a2 + a3)) + ((a4 + a5) + (a6 + a7)); s2 += ((a0 * a0 + a1 * a1) + (a2 * a2 + a3 * a3)) + ((a4 * a4 + a5 * a5) + (a6 * a6 + a7 * a7)); }
        }
        s1 += __shfl_xor(s1, 1); s1 += __shfl_xor(s1, 2); s2 += __shfl_xor(s2, 1); s2 += __shfl_xor(s2, 2);
        const float mean = s1 * (1.f / 768.f), var = fmaxf(s2 * (1.f / 768.f) - mean * mean, 0.f);
        if (qd == 0) { ST[2 * t] = mean; ST[2 * t + 1] = 1.0f / sqrtf(var + EPS); }
    }
    WG_SYNC();
#pragma unroll 1
    for (int g = 0; g < 4; ++g) {
        {
            u32x4 v[6];
#pragma unroll
            for (int i = 0; i < 6; ++i) { const int idx = tid + 512 * i, sr = idx / 24, ch = idx % 24; v[i] = *(const u32x4*)(Zr + (size_t)sr * NZ + ZCV + g * 192 + ch * 8); }
#pragma unroll
            for (int i = 0; i < 6; ++i) { const int idx = tid + 512 * i, sr = idx / 24, ch = idx % 24;
                const float mean = ST[2 * sr], rstd = ST[2 * sr + 1];
                const float* lg = P_sgu_ln_g + l * 768 + g * 192 + ch * 8; const float* lb = P_sgu_ln_b + l * 768 + g * 192 + ch * 8;
                const f32x4 g0 = *(const f32x4*)lg, g1 = *(const f32x4*)(lg + 4), b0 = *(const f32x4*)lb, b1 = *(const f32x4*)(lb + 4);
                u32x4 o;
                o.x = cvt_pk_bf16((gelu_tanh(bflo(v[i].x)) - mean) * rstd * g0.x + b0.x, (gelu_tanh(bfhi(v[i].x)) - mean) * rstd * g0.y + b0.y);
                o.y = cvt_pk_bf16((gelu_tanh(bflo(v[i].y)) - mean) * rstd * g0.z + b0.z, (gelu_tanh(bfhi(v[i].y)) - mean) * rstd * g0.w + b0.w);
                o.z = cvt_pk_bf16((gelu_tanh(bflo(v[i].z)) - mean) * rstd * g1.x + b1.x, (gelu_tanh(bfhi(v[i].z)) - mean) * rstd * g1.y + b1.y);
                o.w = cvt_pk_bf16((gelu_tanh(bflo(v[i].w)) - mean) * rstd * g1.z + b1.z, (gelu_tanh(bfhi(v[i].w)) - mean) * rstd * g1.w + b1.w);
                *(LAS u32x4*)(VN + sr * SG_V_P + ch * 16) = o; }
        }
        WG_SYNC();
        const float* Wg = P_sgu_w + ((size_t)l * 4 + g) * 128 * 128;
#pragma unroll 1
        for (int half = 0; half < 2; ++half) {
            const int tt = half == 0 ? w : 7 - w, nks = (tt >> 1) + 1, t = 16 * tt + fr;
            bf16x8 wf[4];
#pragma unroll
            for (int ks = 0; ks < 4; ++ks) {
                u32x4 pw = (u32x4){0u, 0u, 0u, 0u};
                if (ks < nks) { const float* wp = Wg + (size_t)t * 128 + 32 * ks + 8 * fq; const f32x4 a = *(const f32x4*)wp, c4 = *(const f32x4*)(wp + 4); const int s0 = 32 * ks + 8 * fq;
                    pw.x = cvt_pk_bf16(s0 + 0 <= t ? a.x : 0.f, s0 + 1 <= t ? a.y : 0.f); pw.y = cvt_pk_bf16(s0 + 2 <= t ? a.z : 0.f, s0 + 3 <= t ? a.w : 0.f);
                    pw.z = cvt_pk_bf16(s0 + 4 <= t ? c4.x : 0.f, s0 + 5 <= t ? c4.y : 0.f); pw.w = cvt_pk_bf16(s0 + 6 <= t ? c4.z : 0.f, s0 + 7 <= t ? c4.w : 0.f); }
                wf[ks] = __builtin_bit_cast(bf16x8, pw);
            }
            const float bs = P_sgu_b[((size_t)l * 4 + g) * 128 + t];
            const bf16_t* up = Zr + (size_t)t * NZ + ZCU + g * 192 + 8 * fq;
            bf16_t* op = P_OMIX + (row0 + t) * D + 1280 + g * 192 + 8 * fq;
            u32x4 uv[3];
#pragma unroll
            for (int kk = 0; kk < 3; ++kk) uv[kk] = *(const u32x4*)(up + 32 * (3 * half + kk));
#pragma unroll
            for (int kk = 0; kk < 3; ++kk) {
                const int k = 3 * half + kk;
                f32x4 a0 = (f32x4){0.f, 0.f, 0.f, 0.f}, a1 = (f32x4){0.f, 0.f, 0.f, 0.f};
#pragma unroll
                for (int ks = 0; ks < 4; ++ks) if (ks < nks) { a0 = __builtin_amdgcn_mfma_f32_16x16x32_bf16(tr_frag_p(VN, SG_V_P, 32 * ks, k, 0, lane), wf[ks], a0, 0, 0, 0);
                                                                 a1 = __builtin_amdgcn_mfma_f32_16x16x32_bf16(tr_frag_p(VN, SG_V_P, 32 * ks, k, 1, lane), wf[ks], a1, 0, 0, 0); }
                u32x4 wv; wv.x = cvt_pk_bf16(gelu_tanh(bflo(uv[kk].x)) * (a0[0] + bs), gelu_tanh(bfhi(uv[kk].x)) * (a0[1] + bs)); wv.y = cvt_pk_bf16(gelu_tanh(bflo(uv[kk].y)) * (a0[2] + bs), gelu_tanh(bfhi(uv[kk].y)) * (a0[3] + bs));
                wv.z = cvt_pk_bf16(gelu_tanh(bflo(uv[kk].z)) * (a1[0] + bs), gelu_tanh(bfhi(uv[kk].z)) * (a1[1] + bs)); wv.w = cvt_pk_bf16(gelu_tanh(bflo(uv[kk].w)) * (a1[2] + bs), gelu_tanh(bfhi(uv[kk].w)) * (a1[3] + bs));
                *(u32x4*)(op + 32 * k) = wv;
            }
        }
        WG_SYNC();
    }
}
__device__ __forceinline__ void attn_combine(Frame& F) {
    const size_t ntask = (size_t)M * 64;
    const float* LSEp = P_LSE; const bf16_t* AOp = P_AO; bf16_t* OMp = P_OMIX;
    for (size_t task = (size_t)F.bid * NT + opq_tid(); task < ntask; task += (size_t)F.G * NT) {
        const size_t row = task >> 6; const int ch = (int)(task & 63), h = ch >> 4;
        const float l0 = LSEp[((size_t)0 * M + row) * 4 + h], l1 = LSEp[((size_t)1 * M + row) * 4 + h], l2 = LSEp[((size_t)2 * M + row) * 4 + h];
        const float mx = fmaxf(l0, fmaxf(l1, l2)); const float e0 = __expf(l0 - mx), e1 = __expf(l1 - mx), e2 = __expf(l2 - mx); const float inv = 1.0f / (e0 + e1 + e2);
        const float w0 = e0 * inv, w1 = e1 * inv, w2 = e2 * inv;
        const u32x4 a = *(const u32x4*)(AOp + ((size_t)0 * M + row) * 512 + ch * 8), bq = *(const u32x4*)(AOp + ((size_t)1 * M + row) * 512 + ch * 8), cq = *(const u32x4*)(AOp + ((size_t)2 * M + row) * 512 + ch * 8);
        u32x4 o;
        o.x = cvt_pk_bf16(w0 * bflo(a.x) + w1 * bflo(bq.x) + w2 * bflo(cq.x), w0 * bfhi(a.x) + w1 * bfhi(bq.x) + w2 * bfhi(cq.x));
        o.y = cvt_pk_bf16(w0 * bflo(a.y) + w1 * bflo(bq.y) + w2 * bflo(cq.y), w0 * bfhi(a.y) + w1 * bfhi(bq.y) + w2 * bfhi(cq.y));
        o.z = cvt_pk_bf16(w0 * bflo(a.z) + w1 * bflo(bq.z) + w2 * bflo(cq.z), w0 * bfhi(a.z) + w1 * bfhi(bq.z) + w2 * bfhi(cq.z));
        o.w = cvt_pk_bf16(w0 * bflo(a.w) + w1 * bflo(bq.w) + w2 * bflo(cq.w), w0 * bfhi(a.w) + w1 * bfhi(bq.w) + w2 * bfhi(cq.w));
        *(u32x4*)(OMp + row * D + ch * 8) = o;
    }
}

constexpr int NPH = 10;
__global__ void __launch_bounds__(NT, 2) mega_fwd(Args args) {
    extern __shared__ __attribute__((aligned(16))) unsigned char lds_raw[];
    Frame F;
    F.lds = (LAS unsigned char*)lds_raw;
    F.G = gridDim.x; F.bid = blockIdx.x;
    unsigned char* ws = args.ws;
    volatile LAS unsigned* MISC = (volatile LAS unsigned*)(F.lds + LDS_MISC);
    if (threadIdx.x < 16) MISC[threadIdx.x] = 0u;
    __syncthreads();
    unsigned* ctl = (unsigned*)(ws + WS_CTL);
    const bool single = (args.ph_hi - args.ph_lo) > 1 || (args.l_hi - args.l_lo) > 1;
    XcdBarrier bar; bar.bar = ctl + CW_BAR; bar.x = 0; bar.st = nullptr;
    if (single) bar = xcd_barrier_post(ctl + CW_BAR, MISC);
#ifndef REP_MIX
#define REP_MIX 1
#endif
#ifndef REP_G1
#define REP_G1 1
#endif
#ifndef REP_THIN
#define REP_THIN 1
#endif
#ifndef REP_ATT
#define REP_ATT 1
#endif
#ifndef REP_GLA1
#define REP_GLA1 1
#endif
#ifndef REP_SGU
#define REP_SGU 1
#endif
#ifndef REP_SCAN
#define REP_SCAN 1
#endif
#ifndef REP_G3
#define REP_G3 1
#endif
#ifndef REP_CMB
#define REP_CMB 1
#endif
#ifndef REP_P5
#define REP_P5 1
#endif
#ifndef REP_P8
#define REP_P8 1
#endif
#ifndef PH_MASK
#define PH_MASK 0x3ff
#endif
#define IN(k) (((PH_MASK >> (k)) & 1) && args.ph_lo <= (k) && (k) < args.ph_hi)
#define GRID_BAR() do { if (single) xcd_barrier(bar); } while (0)

    for (int l = args.l_lo; l < args.l_hi; ++l) {
        for (int rp = 0; rp < REP_THIN; ++rp)
        if (IN(0)) { p0_convert(F, l); if (l == 0) cast_rows(F, P_x, P_XN, P_RS1, P_XB8); GRID_BAR(); }
        for (int rp = 0; rp < REP_G1; ++rp)
        if (IN(1)) {
            {
                pg8::Gemm g{P_XB8, P_W8, M, N8, D, D, D}; pg8::StaticOrder S; S.init(M, N8, F.G, F.bid); S.wgm = 8;
                if (F.G == 256) { S.full = 20; S.c0 = 128; S.extra = 2; }
                pg8::EpiStoreBf16 E{P_Z, NZ, P_RS1 + (size_t)l * M, 18, 0, ZGA, W8_INV};
                pg8::gemm_phase<pg8::EpiStoreBf16, true, true>(F.lds, g, S, E);
            }
            {
                pg8::Gemm g{P_XN, P_WIN, M, NB, D, D, D}; pg8::StaticOrder S; S.init(M, NB, F.G, F.bid); S.wgm = 8;
                pg8::EpiStoreBf16 E{P_Z, NZ, P_RS1 + (size_t)l * M, 12, ZBQ, ZGL, 1.0f};
                pg8::gemm_phase<pg8::EpiStoreBf16, true, false>(F.lds, g, S, E);
            }
            GRID_BAR();
        }
        for (int rp = 0; rp < REP_MIX; ++rp) {
        if (IN(2)) {
            for (int q = 0; q < REP_ATT; ++q) for (int u = F.bid; u < 768; u += F.G) attn_seg(F, u, l);
            for (int q = 0; q < REP_GLA1; ++q) for (int u = F.bid; u < 2048; u += F.G) gla1_unit(F, u, l);
            for (int q = 0; q < REP_SGU; ++q) for (int u = F.bid; u < 256; u += F.G) sgu_unit(F, u, l);
            GRID_BAR();
        }
        if (IN(3)) { for (int q = 0; q < REP_SCAN; ++q) gla_scan(F); GRID_BAR(); }
        if (IN(4)) {
            for (int q = 0; q < REP_G3; ++q) for (int u = F.bid; u < 1024; u += F.G) gla3_unit(F, u, l);
            for (int q = 0; q < REP_CMB; ++q) attn_combine(F);
            GRID_BAR();
        }
        }
        for (int rp = 0; rp < REP_P5; ++rp)
        if (IN(5)) {
            {
                pg8::Gemm g{P_OMIX, P_WBR, M, D, D, D, D}; pg8::StaticOrder S; S.init(M, D, F.G, F.bid); S.nbr = 3;
                pg8::EpiGate E{P_Y, P_Z + ZGA, D, NZ};
                pg8::gemm_phase<pg8::EpiGate, true, false, true>(F.lds, g, S, E);
            }
            GRID_BAR();
        }
        if (IN(6)) {
            pg8::Gemm g{P_Y, P_WO, M, D, D, D, D}; pg8::StaticOrder S; S.init(M, D, F.G, F.bid);
            pg8::EpiRes E{P_XN, (float*)nullptr, D, P_RS2 + (size_t)l * M, (unsigned char*)nullptr};
            pg8::gemm_phase<pg8::EpiRes, true>(F.lds, g, S, E);
            GRID_BAR();
        }
        for (int rp = 0; rp < REP_THIN; ++rp)
        if (IN(7)) { }
        for (int rp = 0; rp < REP_P8; ++rp)
        if (IN(8)) {
            pg8::Gemm g{P_XN, P_WFI, M, NFI, D, D, D}; pg8::StaticOrder S; S.init(M, NFI, F.G, F.bid); S.wgm = 8;
            pg8::EpiSwiGLU E{P_H, DFF, P_RS2 + (size_t)l * M};
            pg8::gemm_phase<pg8::EpiSwiGLU, true>(F.lds, g, S, E);
            GRID_BAR();
        }
        if (IN(9)) {
            pg8::Gemm g{P_H, P_WFO, M, D, DFF, DFF, DFF}; pg8::StaticOrder S; S.init(M, D, F.G, F.bid);
            pg8::EpiRes E{P_XN, (l + 1 < DEPTH) ? (float*)nullptr : P_out, D, P_RS1 + (size_t)(l + 1 < DEPTH ? l + 1 : 0) * M, (l + 1 < DEPTH) ? P_XB8 : (unsigned char*)nullptr};
            pg8::gemm_phase<pg8::EpiRes, true>(F.lds, g, S, E);
            GRID_BAR();
        }
    }
#undef IN
#undef GRID_BAR
}

extern "C" void kernel_launch(void* const* d_in, const int* in_sizes, int n_in, void* d_out, int out_size, void* d_ws, size_t ws_size, hipStream_t stream) {
    static int grid = 0;
    if (grid == 0) {
        if (n_in != 18 || out_size != M * D || ws_size < WS_END) { fprintf(stderr, "kernel_launch: unexpected shapes (n_in %d, out %d, ws %zu < %zu)\n", n_in, out_size, ws_size, (size_t)WS_END); grid = -1; return; }
        int dev = 0, cus = 0, per_cu = 0;
        if (hipGetDevice(&dev) != hipSuccess || hipDeviceGetAttribute(&cus, hipDeviceAttributeMultiprocessorCount, dev) != hipSuccess) { grid = -1; return; }
        if (hipFuncSetAttribute((const void*)mega_fwd, hipFuncAttributeMaxDynamicSharedMemorySize, LDS_BYTES) != hipSuccess) { fprintf(stderr, "kernel_launch: hipFuncSetAttribute failed\n"); grid = -1; return; }
        if (hipOccupancyMaxActiveBlocksPerMultiprocessor(&per_cu, (const void*)mega_fwd, NT, LDS_BYTES) != hipSuccess || per_cu < 1) { fprintf(stderr, "kernel_launch: occupancy query says %d\n", per_cu); }
        (void)hipGetLastError();
        grid = cus;
    }
    if (grid < 0) return;
    (void)hipMemsetAsync((char*)d_ws + WS_CTL, 0, CTL_ZERO_BYTES, stream);
    Args a{};
    for (int i = 0; i < 18; ++i) a.in[i] = (const float*)d_in[i];
    a.out = (float*)d_out; a.ws = (unsigned char*)d_ws;
#if MK_MULTI
    for (int l = 0; l < DEPTH; ++l)
        for (int p = 0; p < NPH; ++p) { a.l_lo = l; a.l_hi = l + 1; a.ph_lo = p; a.ph_hi = p + 1; hipLaunchKernelGGL(mega_fwd, dim3(grid), dim3(NT), LDS_BYTES, stream, a); }
#else
    a.l_lo = 0; a.l_hi = DEPTH; a.ph_lo = 0; a.ph_hi = NPH;
    hipLaunchKernelGGL(mega_fwd, dim3(grid), dim3(NT), LDS_BYTES, stream, a);
#endif
}
```
